# Optimizing an MI355X kernel written in HIP

```python
import math
import jax, jax.numpy as jnp
from jax import lax
import numpy as np

D_MODEL = 1024
BATCH = 32
SEQ = 2048
DEPTH = 1

HEAD_DIM = 64
MOBA_HEADS = 8
MOBA_WIDTH = MOBA_HEADS * HEAD_DIM
MOBA_BLOCK = 256
MOBA_TOPK = 3
MOBA_QCHUNK = 128
DIFF_HEADS = 4
DIFF_QK_DIM = HEAD_DIM
DIFF_V_DIM = 2 * HEAD_DIM
DIFF_WIDTH = DIFF_HEADS * DIFF_V_DIM
MIX_WIDTH = MOBA_WIDTH + DIFF_WIDTH
DIFF_QK_COLS = DIFF_HEADS * 2 * DIFF_QK_DIM
IN_COLS = 3 * MOBA_WIDTH + 2 * DIFF_QK_COLS + DIFF_WIDTH
ATTN_QBLOCK = 128
MEM_LEN = 256
MEM_HEADS = 4
MEM_HEAD_DIM = D_MODEL // MEM_HEADS
N_GROUPS = 4
EXPERTS_PER_GROUP = 8
N_EXPERTS = N_GROUPS * EXPERTS_PER_GROUP
TOPK_IN_GROUP = 2
EXPERT_FF = D_MODEL // 2
RMS_EPS = 1e-6
NEG_INF = -1e30

kernel_name = 'hymba_moba_diff_hmoe_block'


def _rmsnorm(x, g):
    xf = x.astype(jnp.float32)
    y = xf * lax.rsqrt(jnp.mean(xf * xf, axis=-1, keepdims=True) + RMS_EPS)
    return (y * g.astype(jnp.float32)).astype(x.dtype)


def _alibi_slopes(n):
    return jnp.asarray(np.array([2.0 ** (-8.0 * (i + 1) / n) for i in range(n)], dtype=np.float32))


def _lambda_init(layer):
    return 0.8 - 0.6 * math.exp(-0.3 * layer)


def _moba_attention(q, k, v):
    B, S, H, D = q.shape
    L = MOBA_BLOCK
    QC = MOBA_QCHUNK
    nblk = -(-S // L)
    s_pad = nblk * L
    nchunk = S // QC
    n_sel = min(MOBA_TOPK, nblk)
    scale = D ** -0.5
    slopes = _alibi_slopes(H)
    pad = ((0, 0), (0, s_pad - S), (0, 0), (0, 0))
    kb = jnp.pad(k, pad).reshape(B, nblk, L, H, D).transpose(0, 3, 1, 2, 4)
    vb = jnp.pad(v, pad).reshape(B, nblk, L, H, D).transpose(0, 3, 1, 2, 4)
    k_mean = jnp.mean(kb.astype(jnp.float32), axis=3)
    gate = jnp.einsum('bshd,bhnd->bhsn', q.astype(jnp.float32), k_mean)
    q_blk = jnp.arange(S) // L
    fully_past = jnp.arange(nblk)[None, :] < q_blk[:, None]
    gate = jnp.where(fully_past[None, None], gate, NEG_INF)
    _, sel = lax.top_k(gate, n_sel)
    q_items = q.reshape(B, nchunk, QC, H, D).transpose(0, 1, 3, 2, 4).reshape(B * nchunk, H, QC, D)
    sel_items = sel.reshape(B, H, nchunk, QC, n_sel).transpose(0, 2, 1, 3, 4).reshape(B * nchunk, H, QC, n_sel)
    b_items = jnp.repeat(jnp.arange(B, dtype=jnp.int32), nchunk)
    c_items = jnp.tile(jnp.arange(nchunk, dtype=jnp.int32), B)
    offs = jnp.arange(L)
    h_idx = jnp.arange(H)[:, None, None]
    slot = jnp.arange(n_sel)

    def one_chunk(item):
        qc, sc, bi, ci = item
        kbb = kb[bi]
        vbb = vb[bi]
        t = ci * QC + jnp.arange(QC)
        own = (ci * QC) // L
        k_g = kbb[h_idx, sc]
        v_g = vbb[h_idx, sc]
        k_own = lax.dynamic_index_in_dim(kbb, own, axis=1, keepdims=False)
        v_own = lax.dynamic_index_in_dim(vbb, own, axis=1, keepdims=False)
        s_g = jnp.einsum('hqd,hqnld->hqnl', qc, k_g, preferred_element_type=jnp.float32) * scale
        s_own = jnp.einsum('hqd,hld->hql', qc, k_own, preferred_element_type=jnp.float32) * scale
        dist_g = (t[None, :, None, None] - (sc[..., None] * L + offs)).astype(jnp.float32)
        dist_own = (t[:, None] - (own * L + offs)[None, :]).astype(jnp.float32)
        s_g = s_g - slopes[:, None, None, None] * dist_g
        s_own = s_own - slopes[:, None, None] * dist_own[None]
        s_g = jnp.where((slot < own)[None, None, :, None], s_g, NEG_INF)
        s_own = jnp.where(dist_own[None] >= 0, s_own, NEG_INF)
        scores = jnp.concatenate([s_g.reshape(H, QC, n_sel * L), s_own], axis=-1)
        p = jax.nn.softmax(scores, axis=-1)
        p_g = p[..., :n_sel * L].reshape(H, QC, n_sel, L)
        p_own = p[..., n_sel * L:]
        o = (jnp.einsum('hqnl,hqnld->hqd', p_g, v_g.astype(jnp.float32))
             + jnp.einsum('hql,hld->hqd', p_own, v_own.astype(jnp.float32)))
        return o.astype(qc.dtype)

    o = lax.map(one_chunk, (q_items, sel_items, b_items, c_items))
    return o.reshape(B, nchunk, H, QC, D).transpose(0, 1, 3, 2, 4).reshape(B, S, H * D)


def _diff_attention(q, k, v, lam, subln_w, lam_init):
    B, S, H, _, Dq = q.shape
    QB = ATTN_QBLOCK
    nqb = S // QB
    scale = Dq ** -0.5
    slopes = _alibi_slopes(H)
    k_pos = jnp.arange(S)
    vf = v.astype(jnp.float32)
    q_blocks = q.reshape(B, nqb, QB, H, 2, Dq).transpose(1, 0, 2, 3, 4, 5)

    def one_block(item):
        qb, i = item
        t = i * QB + jnp.arange(QB)
        dist = (t[:, None] - k_pos[None, :]).astype(jnp.float32)
        s = jnp.einsum('bqhcd,bkhcd->bhcqk', qb, k, preferred_element_type=jnp.float32) * scale
        s = s - slopes[None, :, None, None, None] * dist
        s = jnp.where(dist >= 0, s, NEG_INF)
        p = jax.nn.softmax(s, axis=-1)
        a = p[:, :, 0] - lam * p[:, :, 1]
        return jnp.einsum('bhqk,bkhd->bqhd', a, vf)

    o = lax.map(one_block, (q_blocks, jnp.arange(nqb)))
    o = o.transpose(1, 0, 2, 3, 4).reshape(B, S, H, -1)
    o = _rmsnorm(o, subln_w) * (1.0 - lam_init)
    return o.reshape(B, S, -1).astype(v.dtype)


def _memory_cross_attention(xn, memn, w_q, w_kv, w_o):
    B, S, _ = xn.shape
    M = memn.shape[1]
    q = (xn @ w_q).reshape(B, S, MEM_HEADS, MEM_HEAD_DIM)
    kv = (memn @ w_kv).reshape(B, M, 2, MEM_HEADS, MEM_HEAD_DIM)
    s = jnp.einsum('bshd,bmhd->bhsm', q, kv[:, :, 0], preferred_element_type=jnp.float32) * MEM_HEAD_DIM ** -0.5
    p = jax.nn.softmax(s, axis=-1)
    o = jnp.einsum('bhsm,bmhd->bshd', p, kv[:, :, 1].astype(jnp.float32))
    return o.reshape(B, S, D_MODEL).astype(xn.dtype) @ w_o


def _hierarchical_moe(xn, w_rg, b_rg, w_re, b_re, w_gate, w_up, w_down):
    B, S, D = xn.shape
    xf = xn.astype(jnp.float32)
    g_logits = xf @ w_rg.astype(jnp.float32) + b_rg.astype(jnp.float32)
    g_prob = jax.nn.softmax(g_logits, axis=-1)
    g_onehot = jax.nn.one_hot(jnp.argmax(g_logits, axis=-1), N_GROUPS, dtype=jnp.float32)
    g_w = jnp.sum(g_prob * g_onehot, axis=-1, keepdims=True)
    e_logits = (xf @ w_re.astype(jnp.float32) + b_re.astype(jnp.float32)).reshape(B, S, N_GROUPS, EXPERTS_PER_GROUP)
    e_in = jnp.sum(e_logits * g_onehot[..., None], axis=2)
    top_v, top_i = lax.top_k(e_in, TOPK_IN_GROUP)
    top_w = jax.nn.softmax(top_v, axis=-1)
    within = jnp.sum(jax.nn.one_hot(top_i, EXPERTS_PER_GROUP, dtype=jnp.float32) * top_w[..., None], axis=-2)
    combine = (g_onehot[..., :, None] * within[..., None, :] * g_w[..., None]).reshape(B, S, N_EXPERTS)
    w_down_f = w_down.astype(jnp.float32)

    def per_row(item):
        xr, cr = item
        hg = jnp.einsum('sd,edf->sef', xr, w_gate, preferred_element_type=jnp.float32)
        hu = jnp.einsum('sd,edf->sef', xr, w_up, preferred_element_type=jnp.float32)
        hh = jax.nn.silu(hg) * hu * cr[..., None]
        return jnp.einsum('sef,efd->sd', hh, w_down_f).astype(xr.dtype)

    return lax.map(per_row, (xn, combine))


def setup_inputs(seed: int = 0) -> dict:
    key = jax.random.key(seed)
    ks = jax.random.split(key, 25)
    f32 = jnp.float32

    def nrm(k, shape, scale):
        return jax.random.normal(k, shape, f32) * scale

    def gain(k, shape):
        return 1.0 + 0.02 * jax.random.normal(k, shape, f32)

    L = DEPTH
    D = D_MODEL
    return {
        'x': nrm(ks[0], (BATCH, SEQ, D), 1.0),
        'mem': nrm(ks[1], (BATCH, MEM_LEN, D), 1.0),
        'norm_mix': gain(ks[2], (L, D)),
        'w_in': nrm(ks[3], (L, D, IN_COLS), D ** -0.5),
        'lambda_q1': nrm(ks[4], (L, DIFF_QK_DIM), 0.1),
        'lambda_k1': nrm(ks[5], (L, DIFF_QK_DIM), 0.1),
        'lambda_q2': nrm(ks[6], (L, DIFF_QK_DIM), 0.1),
        'lambda_k2': nrm(ks[7], (L, DIFF_QK_DIM), 0.1),
        'diff_subln': gain(ks[8], (L, DIFF_V_DIM)),
        'norm_moba_out': gain(ks[9], (L, MOBA_WIDTH)),
        'w_out': nrm(ks[10], (L, MIX_WIDTH, D), MIX_WIDTH ** -0.5),
        'norm_mem_q': gain(ks[11], (L, D)),
        'norm_mem_kv': gain(ks[12], (L, D)),
        'w_mem_q': nrm(ks[13], (L, D, D), D ** -0.5),
        'w_mem_kv': nrm(ks[14], (L, D, 2 * D), D ** -0.5),
        'w_mem_o': nrm(ks[15], (L, D, D), D ** -0.5),
        'norm_ffn': gain(ks[16], (L, D)),
        'w_router_group': nrm(ks[17], (L, D, N_GROUPS), D ** -0.5),
        'b_router_group': nrm(ks[18], (L, N_GROUPS), 0.01),
        'w_router_expert': nrm(ks[19], (L, D, N_EXPERTS), D ** -0.5),
        'b_router_expert': nrm(ks[20], (L, N_EXPERTS), 0.01),
        'w_expert_gate': nrm(ks[21], (L, N_EXPERTS, D, EXPERT_FF), D ** -0.5),
        'w_expert_up': nrm(ks[22], (L, N_EXPERTS, D, EXPERT_FF), D ** -0.5),
        'w_expert_down': nrm(ks[23], (L, N_EXPERTS, EXPERT_FF, D), EXPERT_FF ** -0.5),
        'norm_final': gain(ks[24], (D,)),
    }


def reference(x, mem, norm_mix, w_in, lambda_q1, lambda_k1, lambda_q2, lambda_k2, diff_subln,
              norm_moba_out, w_out, norm_mem_q, norm_mem_kv, w_mem_q, w_mem_kv, w_mem_o,
              norm_ffn, w_router_group, b_router_group, w_router_expert, b_router_expert,
              w_expert_gate, w_expert_up, w_expert_down, norm_final):
    B, S, _ = x.shape
    split_at = [MOBA_WIDTH, 2 * MOBA_WIDTH, 3 * MOBA_WIDTH,
                3 * MOBA_WIDTH + DIFF_QK_COLS, 3 * MOBA_WIDTH + 2 * DIFF_QK_COLS]
    h = x
    for l in range(DEPTH):
        hn = _rmsnorm(h, norm_mix[l])
        proj = hn @ w_in[l]
        qa, ka, va, qd, kd, vd = jnp.split(proj, split_at, axis=-1)
        a_out = _moba_attention(qa.reshape(B, S, MOBA_HEADS, HEAD_DIM),
                                ka.reshape(B, S, MOBA_HEADS, HEAD_DIM),
                                va.reshape(B, S, MOBA_HEADS, HEAD_DIM))
        a_out = _rmsnorm(a_out, norm_moba_out[l])
        lam_init = _lambda_init(l)
        lam = (jnp.exp(jnp.sum(lambda_q1[l].astype(jnp.float32) * lambda_k1[l].astype(jnp.float32)))
               - jnp.exp(jnp.sum(lambda_q2[l].astype(jnp.float32) * lambda_k2[l].astype(jnp.float32)))
               + lam_init)
        d_out = _diff_attention(qd.reshape(B, S, DIFF_HEADS, 2, DIFF_QK_DIM),
                                kd.reshape(B, S, DIFF_HEADS, 2, DIFF_QK_DIM),
                                vd.reshape(B, S, DIFF_HEADS, DIFF_V_DIM),
                                lam, diff_subln[l], lam_init)
        h = h + jnp.concatenate([a_out, d_out], axis=-1) @ w_out[l]
        h = h + _memory_cross_attention(_rmsnorm(h, norm_mem_q[l]), _rmsnorm(mem, norm_mem_kv[l]),
                                        w_mem_q[l], w_mem_kv[l], w_mem_o[l])
        h = h + _hierarchical_moe(_rmsnorm(h, norm_ffn[l]), w_router_group[l], b_router_group[l],
                                  w_router_expert[l], b_router_expert[l],
                                  w_expert_gate[l], w_expert_up[l], w_expert_down[l])
    return _rmsnorm(h, norm_final)
```

```cpp
#include <hip/hip_runtime.h>
#include <cstdio>
#include <cstdint>

#define LAS __attribute__((address_space(3)))
#define GAS __attribute__((address_space(1)))
typedef unsigned short bf16_t;
typedef short bf16x8 __attribute__((ext_vector_type(8)));
typedef short s16x4 __attribute__((ext_vector_type(4)));
typedef float f32x4 __attribute__((ext_vector_type(4)));
typedef float f32x2 __attribute__((ext_vector_type(2)));
typedef float f32x16 __attribute__((ext_vector_type(16)));
typedef unsigned u32x4 __attribute__((ext_vector_type(4)));
typedef unsigned u32x2 __attribute__((ext_vector_type(2)));
typedef int i32x4 __attribute__((ext_vector_type(4)));
typedef int i32x8 __attribute__((ext_vector_type(8)));

constexpr int NTOK = 65536, DM = 1024, SEQ = 2048, NBATCH = 32, PROJW = 3072, MEMLEN = 256, NMEMROW = NBATCH * MEMLEN;
constexpr int NEXP = 32, EFF = 512;
constexpr float RMS_EPS = 1e-6f, LOG2E = 1.4426950408889634f;
constexpr float C2_64 = 0.125f * LOG2E;
constexpr float C2_256 = 0.0625f * LOG2E;
constexpr int HROWS = 131072 + NEXP * 256;

constexpr size_t MiB = 1u << 20;
constexpr size_t WS_CTL = 0, CTL_ZERO_BYTES = 1 * MiB;
constexpr size_t WS_WIN = 2 * MiB, WS_WOUT = 8 * MiB, WS_WQ = 10 * MiB, WS_WKV = 12 * MiB, WS_WO = 16 * MiB, WS_WR = 18 * MiB;
constexpr size_t WS_WGU = 20 * MiB, WS_WD = 84 * MiB, WS_MEMN = 116 * MiB, WS_KVMEM = 132 * MiB;
constexpr size_t WS_KMS = 164 * MiB, WS_SSQA = 166 * MiB, WS_SSQ1 = 168 * MiB, WS_SSQ2 = 172 * MiB;
constexpr size_t WS_INVRX = 176 * MiB;
constexpr size_t WS_ROWTOK = 180 * MiB, WS_ROWW = 188 * MiB, WS_ROWRSTD = 196 * MiB;
constexpr size_t WS_R0 = 204 * MiB;
constexpr size_t WS_H1 = 332 * MiB;
constexpr size_t WS_H2 = 460 * MiB;
constexpr size_t WS_BIG = 588 * MiB;
constexpr size_t WS_QMEM = WS_BIG, WS_OMEM = WS_BIG + 128 * MiB, WS_HID = WS_BIG;
constexpr size_t WS_END = 972 * MiB;
constexpr int CW_BAR = 4096;
constexpr int CW_ECNT = 16384;

constexpr int RING_BYTES = 131072;
constexpr int MISC_OFF = RING_BYTES;
constexpr int LDS_BYTES = 163840;

__device__ __forceinline__ unsigned cvt_pk_bf16(float lo, float hi) { unsigned r; asm volatile("v_cvt_pk_bf16_f32 %0, %1, %2" : "=v"(r) : "v"(lo), "v"(hi)); return r; }
__device__ __forceinline__ unsigned pk4_fp8(float a, float b, float c, float d) {
    a = __builtin_amdgcn_fmed3f(a, -448.f, 448.f); b = __builtin_amdgcn_fmed3f(b, -448.f, 448.f); c = __builtin_amdgcn_fmed3f(c, -448.f, 448.f); d = __builtin_amdgcn_fmed3f(d, -448.f, 448.f);
    int w = 0; w = __builtin_amdgcn_cvt_pk_fp8_f32(a, b, w, false); w = __builtin_amdgcn_cvt_pk_fp8_f32(c, d, w, true); return (unsigned)w; }
constexpr float SW8 = 32.f, SD8 = 16.f, SH8 = 16.f;
__device__ __forceinline__ float bf_lo(unsigned u) { return __uint_as_float(u << 16); }
__device__ __forceinline__ float bf_hi(unsigned u) { return __uint_as_float(u & 0xffff0000u); }
__device__ __forceinline__ float wave_sum(float v) {
#pragma unroll
    for (int o = 1; o < 64; o <<= 1) v += __shfl_xor(v, o);
    return v;
}
__device__ __forceinline__ float xhalf_max(float m) { auto rr = __builtin_amdgcn_permlane32_swap(__float_as_uint(m), __float_as_uint(m), false, false); return fmaxf(__uint_as_float(rr[0]), __uint_as_float(rr[1])); }
__device__ __forceinline__ float xhalf_sum(float m) { auto rr = __builtin_amdgcn_permlane32_swap(__float_as_uint(m), __float_as_uint(m), false, false); return __uint_as_float(rr[0]) + __uint_as_float(rr[1]); }
__device__ __forceinline__ int crow(int r, int hi) { return (r & 3) + 8 * (r >> 2) + 4 * hi; }
#define LDS_WAIT() asm volatile("s_waitcnt lgkmcnt(0)" ::: "memory")
#define VM_WAIT() asm volatile("s_waitcnt vmcnt(0)" ::: "memory")

namespace pg8 {
constexpr int BM = 256, BK = 64, HALF = 128, HTB = HALF * BK * 2, STAGE_BYTES = 8 * HTB, NXCD = 8, WGM = 8;
__host__ __device__ __forceinline__ int lds_byte(int r, int c) { const int st = (r >> 4) * 2 + (c >> 5), rr = r & 15, cc = c & 31, ob = rr * 64 + cc * 2; return st * 1024 + (ob ^ (((ob >> 9) & 1) << 5)); }
__host__ __device__ __forceinline__ void stage_rc(int b, int& R, int& C) { const int st = b / 1024, sb = b % 1024, swz = sb ^ (((sb >> 9) & 1) << 5); R = (st >> 1) * 16 + swz / 64; C = (st & 1) * 32 + (swz % 64) / 2; }
__host__ __device__ __forceinline__ int perm32(int rho) { const int n = rho >> 4, i = rho & 15; return 8 * (i >> 2) + 4 * n + (i & 3); }

struct Unit { int pm, pn; const char* a; const char* b; int e, cnt, row0, ui; };

struct DenseOrder {
    const char* A; const char* Bt; int K; int nM, nN, nwg, G, c; int esz; bool gat;
    __device__ void init(const void* A_, const void* Bt_, int M, int N, int K_, int G_, int c_, int esz_ = 2, bool gat_ = false) { A = (const char*)A_; Bt = (const char*)Bt_; K = K_; nM = M / BM; nN = N / BM; nwg = nM * nN; G = G_; c = c_; esz = esz_; gat = gat_; }
    __device__ bool next(int i, Unit& u) const {
        const long L = (long)i * G + c; if (L >= nwg) return false;
        int wgid = (int)L; { const int q = nwg / NXCD, r = nwg % NXCD, xcd = wgid % NXCD, off = wgid / NXCD; wgid = (xcd < r ? xcd * (q + 1) : r * (q + 1) + (xcd - r) * q) + off; }
        const int nig = WGM * nN, gid = wgid / nig, fm = gid * WGM, gsz = (nM - fm) < WGM ? (nM - fm) : WGM;
        u.pm = fm + ((wgid % nig) % gsz); u.pn = (wgid % nig) / gsz;
        u.a = gat ? A : A + (size_t)u.pm * BM * K * esz; u.b = Bt + (size_t)u.pn * BM * K * esz; u.e = 0; u.cnt = 256; u.row0 = u.pm * BM; u.ui = i; return true;
    }
    __device__ __forceinline__ int rowidx(const Unit& u, int r) const { return u.row0 + r; }
};

template <class Epi, class Sched, bool ALIGN_EPI, bool GATHER, bool MID, bool FP8 = false>
__device__ __forceinline__ void gemm_phase(LAS unsigned char* lds, const int K_, const Sched& S, const Epi& E) {
    int K = K_; if constexpr (FP8) asm volatile("" : "+s"(K));
    const int tid = threadIdx.x, wid = __builtin_amdgcn_readfirstlane(tid >> 6), lane = tid & 63, wr = wid >> 2, wc = wid & 3, fr = lane & 15, fq = lane >> 4;
    const int nt = FP8 ? K / 128 : K / BK;
    constexpr int ESZ = FP8 ? 1 : 2;
    unsigned voffB[2];
#pragma unroll
    for (int i = 0; i < 2; ++i) { int R, C; stage_rc(tid * 16 + i * 8192, R, C); const int Rb = Epi::PERM ? ((R & ~31) + perm32(R & 31)) : R; voffB[i] = FP8 ? (unsigned)(Rb * K + C * 2) : (unsigned)(Rb * K + C) * 2u; }
    const size_t kstep = (size_t)(BK * 2);
    const size_t hstep = (size_t)HALF * K * ESZ;
    const unsigned ldsw = (unsigned)wid * 1024u;
    const int aoff0 = lds_byte(wr * 64 + fr, fq * 8), aoff1 = aoff0 + 1024;
    const int boff0 = lds_byte(wc * 32 + fr, fq * 8), boff1 = boff0 + 1024;
#define PG8_SA(b, h) (((b) * 2 + (h)) * HTB)
#define PG8_SB(b, h) ((4 + (b) * 2 + (h)) * HTB)
#define PG8_STAGE(bufoff, gbase, voff) do { _Pragma("unroll") for (int _i = 0; _i < 2; ++_i) \
        __builtin_amdgcn_global_load_lds((const unsigned*)((const char*)(gbase) + (voff)[_i]), (LAS unsigned*)(lds + (bufoff) + ldsw + _i * 8192), 16, 0, 0); } while (0)
#define PG8_LD8(p) ({ const i32x4 lo_ = *(const LAS i32x4*)(p), hi_ = *(const LAS i32x4*)((p) + 0); (void)hi_; lo_; })
#define PG8_LDA(dst, b, h) do { if constexpr (FP8) { _Pragma("unroll") for (int m = 0; m < 4; ++m) { const i32x4 lo_ = *(const LAS i32x4*)(lds + PG8_SA(b, h) + aoff0 + m * 2048), hi_ = *(const LAS i32x4*)(lds + PG8_SA(b, h) + aoff1 + m * 2048); \
            dst##8[m] = (i32x8){lo_[0], lo_[1], lo_[2], lo_[3], hi_[0], hi_[1], hi_[2], hi_[3]}; } } \
        else { _Pragma("unroll") for (int m = 0; m < 4; ++m) _Pragma("unroll") for (int k = 0; k < 2; ++k) dst[m][k] = *(const LAS bf16x8*)(lds + PG8_SA(b, h) + (k ? aoff1 : aoff0) + m * 2048); } } while (0)
#define PG8_LDB(dst, b, h) do { if constexpr (FP8) { _Pragma("unroll") for (int n = 0; n < 2; ++n) { const i32x4 lo_ = *(const LAS i32x4*)(lds + PG8_SB(b, h) + boff0 + n * 2048), hi_ = *(const LAS i32x4*)(lds + PG8_SB(b, h) + boff1 + n * 2048); \
            dst##8[n] = (i32x8){lo_[0], lo_[1], lo_[2], lo_[3], hi_[0], hi_[1], hi_[2], hi_[3]}; } } \
        else { _Pragma("unroll") for (int n = 0; n < 2; ++n) _Pragma("unroll") for (int k = 0; k < 2; ++k) dst[n][k] = *(const LAS bf16x8*)(lds + PG8_SB(b, h) + (k ? boff1 : boff0) + n * 2048); } } while (0)
#define PG8_MMA(ai, bj, At, Bt) do { __builtin_amdgcn_s_setprio(1); _Pragma("unroll") for (int m = 0; m < 4; ++m) _Pragma("unroll") for (int n = 0; n < 2; ++n) { \
        if constexpr (FP8) acc[ai][bj][m][n] = __builtin_amdgcn_mfma_scale_f32_16x16x128_f8f6f4(Bt##8[n], At##8[m], acc[ai][bj][m][n], 0, 0, 0, 0x7f7f7f7f, 0, 0x7f7f7f7f); \
        else { _Pragma("unroll") for (int k = 0; k < 2; ++k) acc[ai][bj][m][n] = __builtin_amdgcn_mfma_f32_16x16x32_bf16(Bt[n][k], At[m][k], acc[ai][bj][m][n], 0, 0, 0); } } \
        __builtin_amdgcn_s_setprio(0); } while (0)
#define PG8_WAIT_V(n) asm volatile("s_waitcnt vmcnt(" #n ")" ::: "memory")
#define PG8_WAIT_L(n) asm volatile("s_waitcnt lgkmcnt(" #n ")" ::: "memory")
#define PG8_BAR __builtin_amdgcn_s_barrier()
#define PG8_SCHED __builtin_amdgcn_sched_barrier(0)
#define PG8_MKVO(u, vo) do { _Pragma("unroll") for (int _h = 0; _h < 2; ++_h) _Pragma("unroll") for (int _i = 0; _i < 2; ++_i) { int _R, _C; stage_rc(tid * 16 + _i * 8192, _R, _C); const int _r = _h * HALF + _R; \
        const int _src = GATHER ? S.rowidx(u, _r) : _r; vo[_h][_i] = FP8 ? (unsigned)(_src * K + _C * 2) : (unsigned)(_src * K + _C) * 2u; } } while (0)
    Unit cur, nxt; int ui = 0;
    if (!S.next(0, cur)) return;
    f32x4 acc[2][2][4][2];
#pragma unroll
    for (int a = 0; a < 2; ++a)
#pragma unroll
        for (int b = 0; b < 2; ++b)
#pragma unroll
            for (int m = 0; m < 4; ++m)
#pragma unroll
                for (int n = 0; n < 2; ++n) acc[a][b][m][n] = (f32x4){0.f, 0.f, 0.f, 0.f};
    bf16x8 At[4][2], B0[2][2], B1[2][2];
    i32x8 At8[4], B08[2], B18[2];
    unsigned vo[2][2];
    LAS u32x4* nvo_lds = (LAS u32x4*)(lds + STAGE_BYTES + 8192) + tid;
    PG8_MKVO(cur, vo);
    const char* cA = cur.a; const char* cB = cur.b;
    PG8_STAGE(PG8_SB(0, 0), cB, voffB); PG8_STAGE(PG8_SB(0, 1), cB + hstep, voffB); PG8_STAGE(PG8_SA(0, 0), cA, vo[0]); PG8_STAGE(PG8_SA(0, 1), cA, vo[1]);
    if (wr == 1) PG8_BAR;
    PG8_WAIT_V(2); PG8_BAR;
    PG8_STAGE(PG8_SB(1, 0), cB + kstep, voffB); PG8_STAGE(PG8_SA(1, 0), cA + kstep, vo[0]); PG8_STAGE(PG8_SB(1, 1), cB + hstep + kstep, voffB);
    PG8_WAIT_V(6); PG8_BAR;
    for (;;) {
        if constexpr (Epi::HOOK) E.begin(cur, lds + STAGE_BYTES);
        const bool has_next = S.next(ui + 1, nxt);
        const char* nA = has_next ? nxt.a : cA; const char* nB = has_next ? nxt.b : cB;
        if constexpr (GATHER) { unsigned nvo[2][2]; if (has_next) { PG8_MKVO(nxt, nvo); } else {
#pragma unroll
            for (int h = 0; h < 2; ++h)
#pragma unroll
                for (int i = 0; i < 2; ++i) nvo[h][i] = vo[h][i]; }
            *nvo_lds = (u32x4){nvo[0][0], nvo[0][1], nvo[1][0], nvo[1][1]}; }
#pragma unroll 1
        for (int t = 0; t < nt; t += 2) {
            const bool last = (t == nt - 2);
            if constexpr (MID) { if (t == (nt >> 1)) E.mid(acc, cur, wr, fr); }
            const char* a1 = cA + (size_t)(t + 1) * kstep;
            const char* a2 = last ? nA : cA + (size_t)(t + 2) * kstep; const char* b2 = last ? nB : cB + (size_t)(t + 2) * kstep;
            const char* a3 = a2 + kstep; const char* b3 = b2 + kstep;
            PG8_LDB(B0, 0, 0); PG8_LDB(B1, 0, 1); PG8_SCHED; PG8_LDA(At, 0, 0); PG8_STAGE(PG8_SA(1, 1), a1, vo[1]);
            if constexpr (GATHER) { if (last) { const u32x4 nv = *nvo_lds; vo[0][0] = nv.x; vo[0][1] = nv.y; vo[1][0] = nv.z; vo[1][1] = nv.w; } }
            PG8_WAIT_V(8); PG8_WAIT_L(0); PG8_BAR; PG8_MMA(0, 0, At, B0); PG8_MMA(0, 1, At, B1); PG8_BAR; PG8_SCHED;
            PG8_LDA(At, 0, 1); PG8_STAGE(PG8_SB(0, 0), b2, voffB); PG8_STAGE(PG8_SB(0, 1), b2 + hstep, voffB); PG8_STAGE(PG8_SA(0, 0), a2, vo[0]);
            PG8_WAIT_V(8); PG8_WAIT_L(0); PG8_BAR; PG8_MMA(1, 0, At, B0); PG8_MMA(1, 1, At, B1); PG8_BAR; PG8_SCHED;
            PG8_LDB(B0, 1, 0); PG8_LDB(B1, 1, 1); PG8_SCHED; PG8_LDA(At, 1, 0); PG8_STAGE(PG8_SA(0, 1), a2, vo[1]);
            PG8_WAIT_V(8); PG8_WAIT_L(0); PG8_BAR; PG8_MMA(0, 0, At, B0); PG8_MMA(0, 1, At, B1); PG8_BAR; PG8_SCHED;
            PG8_LDA(At, 1, 1); PG8_STAGE(PG8_SB(1, 0), b3, voffB); PG8_STAGE(PG8_SB(1, 1), b3 + hstep, voffB); PG8_STAGE(PG8_SA(1, 0), a3, vo[0]);
            PG8_WAIT_V(8); PG8_WAIT_L(0); PG8_BAR; PG8_MMA(1, 0, At, B0); PG8_MMA(1, 1, At, B1); PG8_BAR; PG8_SCHED;
        }
        if constexpr (ALIGN_EPI) { if (wr == 0) PG8_BAR; }
        if constexpr (!Epi::AFTER_DRAIN) { E(acc, cur, wr, wc, fr, fq); }
        if (!has_next) break;
#pragma unroll
        for (int a = 0; a < 2; ++a)
#pragma unroll
            for (int b = 0; b < 2; ++b)
#pragma unroll
                for (int m = 0; m < 4; ++m)
#pragma unroll
                    for (int n = 0; n < 2; ++n) acc[a][b][m][n] = (f32x4){0.f, 0.f, 0.f, 0.f};
        cur = nxt; cA = nA; cB = nB; ++ui;
        if constexpr (ALIGN_EPI) { if (wr == 1) PG8_BAR; }
    }
    PG8_WAIT_V(0);
    if constexpr (!ALIGN_EPI) { if (wr == 0) PG8_BAR; }
    PG8_BAR;
    if constexpr (Epi::AFTER_DRAIN) { E.fused(acc, cur, wr, wc, fr, fq, lds, wid, lane); }
#undef PG8_SA
#undef PG8_SB
#undef PG8_STAGE
#undef PG8_LDA
#undef PG8_LDB
#undef PG8_MMA
#undef PG8_WAIT_V
#undef PG8_WAIT_L
#undef PG8_BAR
#undef PG8_SCHED
#undef PG8_MKVO
#undef PG8_LD8
}

#define ACC_T const f32x4 (&acc)[2][2][4][2]
__device__ __forceinline__ u32x4 pack8(f32x4 v0, f32x4 v1) { u32x4 w; w.x = cvt_pk_bf16(v0[0], v0[1]); w.y = cvt_pk_bf16(v0[2], v0[3]); w.z = cvt_pk_bf16(v1[0], v1[1]); w.w = cvt_pk_bf16(v1[2], v1[3]); return w; }

constexpr size_t PREG = (size_t)NTOK * 512;
__device__ __forceinline__ size_t proj_off(int c, int& rstride) {
    if (c < 1536) { rstride = 64; return (size_t)(c >> 9) * PREG + (size_t)((c & 511) >> 6) * (SEQ * 64) + (c & 63); }
    if (c < 2560) { const int cc = c - 1536; rstride = 64; return (size_t)(3 + (cc >> 9)) * PREG + (size_t)((cc & 511) >> 6) * (SEQ * 64) + (cc & 63); }
    const int cc = c - 2560; rstride = 128; return 5 * PREG + (size_t)(cc >> 7) * (SEQ * 128) + (cc & 127);
}
struct EpiProj {
    static constexpr bool PERM = true, AFTER_DRAIN = false, HOOK = false;
    bf16_t* O; float* kms;
    __device__ __forceinline__ void operator()(ACC_T, const Unit& u, int wr, int wc, int fr, int fq) const {
        const int pn = u.pn; const float sc = (pn < 2 || (pn >= 6 && pn < 8)) ? C2_64 : 1.f;
        const int bq = u.pm >> 3, s0 = (u.pm & 7) * 256 + wr * 64 + fr;
        bf16_t* ob[2]; int rs[2];
#pragma unroll
        for (int bj = 0; bj < 2; ++bj) { const int c = pn * BM + bj * HALF + wc * 32 + 8 * fq; int st; const size_t off = proj_off(c, st); ob[bj] = O + off + ((size_t)bq << 20); rs[bj] = st; }
#pragma unroll
        for (int ai = 0; ai < 2; ++ai)
#pragma unroll
            for (int m = 0; m < 4; ++m) { const int srow = s0 + ai * HALF + m * 16;
#pragma unroll
                for (int bj = 0; bj < 2; ++bj) *(u32x4*)(ob[bj] + (size_t)srow * rs[bj]) = pack8(acc[ai][bj][m][0] * sc, acc[ai][bj][m][1] * sc); }
        if (pn == 2 || pn == 3) {
            f32x4 cs[2][2];
#pragma unroll
            for (int bj = 0; bj < 2; ++bj)
#pragma unroll
                for (int n = 0; n < 2; ++n) { f32x4 s = (f32x4){0.f, 0.f, 0.f, 0.f};
#pragma unroll
                    for (int ai = 0; ai < 2; ++ai)
#pragma unroll
                        for (int m = 0; m < 4; ++m) s += acc[ai][bj][m][n];
#pragma unroll
                    for (int o = 1; o < 16; o <<= 1) { s[0] += __shfl_xor(s[0], o); s[1] += __shfl_xor(s[1], o); s[2] += __shfl_xor(s[2], o); s[3] += __shfl_xor(s[3], o); }
                    cs[bj][n] = s; }
            if (fr == 0) { float* kp = kms + ((size_t)wr * 256 + u.pm) * 512 + (pn - 2) * 256 + wc * 32 + 8 * fq;
#pragma unroll
                for (int bj = 0; bj < 2; ++bj) { *(f32x4*)(kp + bj * HALF) = cs[bj][0]; *(f32x4*)(kp + bj * HALF + 4) = cs[bj][1]; } }
        }
    }
};
struct EpiPlain {
    static constexpr bool PERM = true, AFTER_DRAIN = false, HOOK = false;
    bf16_t* O; int ldc; float sc;
    __device__ __forceinline__ void operator()(ACC_T, const Unit& u, int wr, int wc, int fr, int fq) const {
        const int row0 = u.pm * BM + wr * 64 + fr, col0 = u.pn * BM + wc * 32 + 8 * fq;
#pragma unroll
        for (int ai = 0; ai < 2; ++ai)
#pragma unroll
            for (int m = 0; m < 4; ++m) { bf16_t* rowp = O + (size_t)(row0 + ai * HALF + m * 16) * ldc + col0;
#pragma unroll
                for (int bj = 0; bj < 2; ++bj) *(u32x4*)(rowp + bj * HALF) = pack8(acc[ai][bj][m][0] * sc, acc[ai][bj][m][1] * sc); }
    }
};
__device__ __forceinline__ void ssq_partial(float q, float* ssq, int row, int slot, int fq) {
    q += __shfl_xor(q, 16); q += __shfl_xor(q, 32);
    if (fq == 0) ssq[(size_t)row * 16 + slot] = q;
}
struct EpiOut {
    static constexpr bool PERM = true, AFTER_DRAIN = false, HOOK = true;
    const bf16_t* hn; const float* invrx; const float* gmix; const float* ssqA; bf16_t* h1; float* ssq1; unsigned char* h1f8; LAS unsigned char* meta;
    __device__ __forceinline__ void begin(const Unit& u, LAS unsigned char*) const {
        if (threadIdx.x < 256) { const int row = u.pm * BM + threadIdx.x;
            const f32x4 a = *(const f32x4*)(ssqA + (size_t)row * 8), b = *(const f32x4*)(ssqA + (size_t)row * 8 + 4);
            const float s = ((a[0] + a[1]) + (a[2] + a[3])) + ((b[0] + b[1]) + (b[2] + b[3]));
            ((LAS f32x2*)(meta + (u.ui & 1) * 2048))[threadIdx.x] = (f32x2){1.0f / sqrtf(s * (1.0f / 512.0f) + RMS_EPS), invrx[row]}; }
    }
    __device__ __forceinline__ void mid(f32x4 (&acc)[2][2][4][2], const Unit& u, int wr, int fr) const {
        const LAS f32x2* mt = (const LAS f32x2*)(meta + (u.ui & 1) * 2048);
#pragma unroll
        for (int ai = 0; ai < 2; ++ai)
#pragma unroll
            for (int m = 0; m < 4; ++m) { const float r = mt[ai * HALF + wr * 64 + m * 16 + fr][0];
#pragma unroll
                for (int bj = 0; bj < 2; ++bj)
#pragma unroll
                    for (int n = 0; n < 2; ++n) acc[ai][bj][m][n] *= r; }
    }
    __device__ __forceinline__ void operator()(ACC_T, const Unit& u, int wr, int wc, int fr, int fq) const {
        const LAS f32x2* mt = (const LAS f32x2*)(meta + (u.ui & 1) * 2048);
        const int row0 = u.pm * BM + wr * 64 + fr, col0 = u.pn * BM + wc * 32 + 8 * fq;
        f32x4 ig[2][2];
#pragma unroll
        for (int bj = 0; bj < 2; ++bj)
#pragma unroll
            for (int n = 0; n < 2; ++n) { const f32x4 g = *(const f32x4*)(gmix + col0 + bj * HALF + 4 * n);
                ig[bj][n] = (f32x4){__builtin_amdgcn_rcpf(g[0]), __builtin_amdgcn_rcpf(g[1]), __builtin_amdgcn_rcpf(g[2]), __builtin_amdgcn_rcpf(g[3])}; }
#pragma unroll
        for (int ai = 0; ai < 2; ++ai) {
            u32x4 hv[4][2];
#pragma unroll
            for (int m = 0; m < 4; ++m) { const size_t off = (size_t)(row0 + ai * HALF + m * 16) * DM + col0;
#pragma unroll
                for (int bj = 0; bj < 2; ++bj) hv[m][bj] = *(const u32x4*)(hn + off + bj * HALF); }
#pragma unroll
            for (int m = 0; m < 4; ++m) { const int row = row0 + ai * HALF + m * 16; const size_t off = (size_t)row * DM + col0; float q = 0.f;
                const float ir = mt[ai * HALF + wr * 64 + m * 16 + fr][1];
#pragma unroll
                for (int bj = 0; bj < 2; ++bj) { const u32x4 hb = hv[m][bj];
                    const f32x4 v0 = acc[ai][bj][m][0] + (f32x4){bf_lo(hb.x), bf_hi(hb.x), bf_lo(hb.y), bf_hi(hb.y)} * ig[bj][0] * ir, v1 = acc[ai][bj][m][1] + (f32x4){bf_lo(hb.z), bf_hi(hb.z), bf_lo(hb.w), bf_hi(hb.w)} * ig[bj][1] * ir;
                    q += (v0[0] * v0[0] + v0[1] * v0[1]) + (v0[2] * v0[2] + v0[3] * v0[3]) + (v1[0] * v1[0] + v1[1] * v1[1]) + (v1[2] * v1[2] + v1[3] * v1[3]);
                    *(u32x4*)(h1 + off + bj * HALF) = pack8(v0, v1);
                    *(u32x2*)(h1f8 + off + bj * HALF) = (u32x2){pk4_fp8(v0[0], v0[1], v0[2], v0[3]), pk4_fp8(v1[0], v1[1], v1[2], v1[3])}; }
                ssq_partial(q, ssq1, row, u.pn * 4 + wc, fq); }
            asm volatile("" ::: "memory"); }
    }
};
__device__ __forceinline__ float rstd_from16(const float* ssq, int row) {
    const f32x4 a = *(const f32x4*)(ssq + (size_t)row * 16), b = *(const f32x4*)(ssq + (size_t)row * 16 + 4), c = *(const f32x4*)(ssq + (size_t)row * 16 + 8), d = *(const f32x4*)(ssq + (size_t)row * 16 + 12);
    const float s = (((a[0] + a[1]) + (a[2] + a[3])) + ((b[0] + b[1]) + (b[2] + b[3]))) + (((c[0] + c[1]) + (c[2] + c[3])) + ((d[0] + d[1]) + (d[2] + d[3])));
    return 1.0f / sqrtf(s * (1.0f / 1024.0f) + RMS_EPS);
}
struct EpiQ {
    static constexpr bool PERM = true, AFTER_DRAIN = false, HOOK = true;
    const float* ssq1; bf16_t* O; LAS unsigned char* misc;
    __device__ __forceinline__ void begin(const Unit& u, LAS unsigned char*) const {
        if (threadIdx.x < 256) ((LAS float*)(misc + ((u.ui & 1) ? 5120 : 3072)))[threadIdx.x] = rstd_from16(ssq1, u.pm * BM + threadIdx.x) * (C2_256 / SW8);
    }
    __device__ __forceinline__ void operator()(ACC_T, const Unit& u, int wr, int wc, int fr, int fq) const {
        const int row0 = u.pm * BM + wr * 64 + fr, col0 = u.pn * BM + wc * 32 + 8 * fq;
        const LAS float* tab = (const LAS float*)(misc + ((u.ui & 1) ? 5120 : 3072));
#pragma unroll
        for (int ai = 0; ai < 2; ++ai)
#pragma unroll
            for (int m = 0; m < 4; ++m) { const float r = tab[ai * HALF + wr * 64 + m * 16 + fr]; bf16_t* rowp = O + (size_t)(row0 + ai * HALF + m * 16) * DM + col0;
#pragma unroll
                for (int bj = 0; bj < 2; ++bj) *(u32x4*)(rowp + bj * HALF) = pack8(acc[ai][bj][m][0] * r, acc[ai][bj][m][1] * r); }
    }
};
struct EpiRes {
    static constexpr bool PERM = true, AFTER_DRAIN = false, HOOK = false;
    const bf16_t* h1; bf16_t* h2; float* ssq2; unsigned char* h2f8; float asc;
    __device__ __forceinline__ void operator()(ACC_T, const Unit& u, int wr, int wc, int fr, int fq) const {
        const int row0 = u.pm * BM + wr * 64 + fr, col0 = u.pn * BM + wc * 32 + 8 * fq;
        u32x4 hv[2][4][2];
#pragma unroll
        for (int ai = 0; ai < 2; ++ai)
#pragma unroll
            for (int m = 0; m < 4; ++m) { const size_t off = (size_t)(row0 + ai * HALF + m * 16) * DM + col0;
#pragma unroll
                for (int bj = 0; bj < 2; ++bj) hv[ai][m][bj] = *(const u32x4*)(h1 + off + bj * HALF); }
#pragma unroll
        for (int ai = 0; ai < 2; ++ai)
#pragma unroll
            for (int m = 0; m < 4; ++m) { const int row = row0 + ai * HALF + m * 16; const size_t off = (size_t)row * DM + col0; float q = 0.f;
#pragma unroll
                for (int bj = 0; bj < 2; ++bj) { const u32x4 hb = hv[ai][m][bj];
                    const f32x4 v0 = acc[ai][bj][m][0] * asc + (f32x4){bf_lo(hb.x), bf_hi(hb.x), bf_lo(hb.y), bf_hi(hb.y)}, v1 = acc[ai][bj][m][1] * asc + (f32x4){bf_lo(hb.z), bf_hi(hb.z), bf_lo(hb.w), bf_hi(hb.w)};
                    q += (v0[0] * v0[0] + v0[1] * v0[1]) + (v0[2] * v0[2] + v0[3] * v0[3]) + (v1[0] * v1[0] + v1[1] * v1[1]) + (v1[2] * v1[2] + v1[3] * v1[3]);
                    *(u32x4*)(h2 + off + bj * HALF) = pack8(v0, v1);
                    *(u32x2*)(h2f8 + off + bj * HALF) = (u32x2){pk4_fp8(v0[0], v0[1], v0[2], v0[3]), pk4_fp8(v1[0], v1[1], v1[2], v1[3])}; }
                ssq_partial(q, ssq2, row, u.pn * 4 + wc, fq); }
    }
};
struct EpiRouter {
    static constexpr bool PERM = false, AFTER_DRAIN = true, HOOK = false;
    const float* ssq2; const float* b_rg; const float* b_re; unsigned* ecnt; int* rowtok; float* roww; float* rowrstd;
    __device__ __forceinline__ void operator()(ACC_T, const Unit&, int, int, int, int) const {}
    __device__ __forceinline__ void fused(f32x4 (&acc)[2][2][4][2], const Unit& u, int wr, int wc, int fr, int fq, LAS unsigned char* lds, int wid, int lane) const {
        LAS float* L = (LAS float*)lds;
        LAS int* lcnt = (LAS int*)(lds + 49152); LAS int* lbase = lcnt + 32;
        const int tid = threadIdx.x;
        if (tid < 32) lcnt[tid] = 0;
        if (wc == 0) {
#pragma unroll
            for (int ai = 0; ai < 2; ++ai)
#pragma unroll
                for (int m = 0; m < 4; ++m) { const int rl = ai * HALF + wr * 64 + m * 16 + fr;
                    *(LAS f32x4*)(L + rl * 40 + 4 * fq) = acc[ai][0][m][0]; *(LAS f32x4*)(L + rl * 40 + 16 + 4 * fq) = acc[ai][0][m][1]; }
        } else if (wc == 1 && fq == 0) {
#pragma unroll
            for (int ai = 0; ai < 2; ++ai)
#pragma unroll
                for (int m = 0; m < 4; ++m) { const int rl = ai * HALF + wr * 64 + m * 16 + fr; *(LAS f32x4*)(L + rl * 40 + 32) = acc[ai][0][m][0]; }
        }
        __syncthreads();
        int e0 = 0, e1 = 0, p0 = 0, p1 = 0; float cw0 = 0.f, cw1 = 0.f, rs = 0.f; const int row = u.pm * BM + tid;
        if (tid < 256) {
            rs = rstd_from16(ssq2, row);
            float gl[4];
#pragma unroll
            for (int g = 0; g < 4; ++g) gl[g] = L[tid * 40 + g] * rs + b_rg[g];
            int grp = 0; float gm = gl[0];
#pragma unroll
            for (int g = 1; g < 4; ++g) if (gl[g] > gm) { gm = gl[g]; grp = g; }
            float gs = 0.f;
#pragma unroll
            for (int g = 0; g < 4; ++g) gs += __expf(gl[g] - gm);
            const float gw = 1.0f / gs;
            float ev[8];
#pragma unroll
            for (int i = 0; i < 8; ++i) ev[i] = L[tid * 40 + 4 + grp * 8 + i] * rs + b_re[grp * 8 + i];
            int i0 = 0; float v0 = ev[0];
#pragma unroll
            for (int i = 1; i < 8; ++i) if (ev[i] > v0) { v0 = ev[i]; i0 = i; }
            int i1 = -1; float v1 = -3.0e38f;
#pragma unroll
            for (int i = 0; i < 8; ++i) if (i != i0 && ev[i] > v1) { v1 = ev[i]; i1 = i; }
            const float w0 = 1.0f / (1.0f + __expf(v1 - v0)), w1 = 1.0f - w0;
            e0 = grp * 8 + i0; e1 = grp * 8 + i1; cw0 = gw * w0; cw1 = gw * w1;
            p0 = __hip_atomic_fetch_add(&lcnt[e0], 1, __ATOMIC_RELAXED, __HIP_MEMORY_SCOPE_WORKGROUP); p1 = __hip_atomic_fetch_add(&lcnt[e1], 1, __ATOMIC_RELAXED, __HIP_MEMORY_SCOPE_WORKGROUP);
        }
        __syncthreads();
        if (tid < 32) lbase[tid] = (int)__hip_atomic_fetch_add(ecnt + tid, (unsigned)lcnt[tid], __ATOMIC_RELAXED, __HIP_MEMORY_SCOPE_AGENT);
        __syncthreads();
        if (tid < 256) {
            const int q0 = lbase[e0] + p0, q1 = lbase[e1] + p1;
            rowtok[(size_t)e0 * NTOK + q0] = row * 2; roww[(size_t)e0 * NTOK + q0] = cw0; rowrstd[(size_t)e0 * NTOK + q0] = rs;
            rowtok[(size_t)e1 * NTOK + q1] = row * 2 + 1; roww[(size_t)e1 * NTOK + q1] = cw1; rowrstd[(size_t)e1 * NTOK + q1] = rs;
        }
    }
};
struct MoeOrder {
    const LAS int* tab; const char* A; const char* Bt; const int* rowtok; int K, G, c; bool up; int esz;
    __device__ __forceinline__ bool next(int i, Unit& u) const {
        if (i >= 16) return false;
        const i32x4 t0 = *(const LAS i32x4*)(tab + 128 + 8 * i); const int r0 = tab[128 + 8 * i + 4];
        const int e = __builtin_amdgcn_readfirstlane(t0[0]); if (e < 0) return false;
        const int rt = __builtin_amdgcn_readfirstlane(t0[1]), pn = __builtin_amdgcn_readfirstlane(t0[2]);
        u.ui = i; u.e = e; u.pm = rt; u.pn = pn; u.cnt = __builtin_amdgcn_readfirstlane(t0[3]); u.row0 = __builtin_amdgcn_readfirstlane(r0);
        u.b = Bt + ((size_t)e * 1024 + (size_t)pn * 256) * K * esz;
        u.a = A;
        return true;
    }
    __device__ __forceinline__ int rowidx(const Unit& u, int r) const { return up ? (rowtok[(size_t)u.e * NTOK + u.pm * 256 + min(r, u.cnt - 1)] >> 1) : u.row0 + r; }
};
struct EpiUp {
    static constexpr bool PERM = true, AFTER_DRAIN = false, HOOK = true;
    const float* roww; const float* rowrstd; unsigned char* H; LAS unsigned char* meta;
    __device__ __forceinline__ void begin(const Unit& u, LAS unsigned char*) const {
        if (threadIdx.x < 256) { const size_t li = (size_t)u.e * NTOK + u.pm * 256 + min((int)threadIdx.x, u.cnt - 1);
            ((LAS f32x2*)(meta + (u.ui & 1) * 2048))[threadIdx.x] = (f32x2){rowrstd[li] * (1.0f / SW8), roww[li] * SH8}; }
    }
    __device__ __forceinline__ void operator()(ACC_T, const Unit& u, int wr, int wc, int fr, int fq) const {
        const LAS f32x2* mt = (const LAS f32x2*)(meta + (u.ui & 1) * 2048);
#pragma unroll
        for (int ai = 0; ai < 2; ++ai)
#pragma unroll
            for (int m = 0; m < 4; ++m) { const int rl = ai * HALF + wr * 64 + m * 16 + fr;
                if (rl < u.cnt) { const f32x2 mv = mt[rl]; const float rs = mv[0], w = mv[1];
                    f32x4 o[2];
#pragma unroll
                    for (int n = 0; n < 2; ++n)
#pragma unroll
                        for (int j = 0; j < 4; ++j) { const float g = acc[ai][0][m][n][j] * rs, up = acc[ai][1][m][n][j] * rs;
                            o[n][j] = g * __builtin_amdgcn_rcpf(1.0f + __builtin_amdgcn_exp2f(-g * LOG2E)) * up * w; }
                    *(u32x2*)(H + (size_t)(u.row0 + rl) * EFF + u.pn * 128 + wc * 32 + 8 * fq) = (u32x2){pk4_fp8(o[0][0], o[0][1], o[0][2], o[0][3]), pk4_fp8(o[1][0], o[1][1], o[1][2], o[1][3])}; } }
    }
};
struct EpiDown {
    static constexpr bool PERM = true, AFTER_DRAIN = false, HOOK = true;
    const int* rowtok; unsigned char* y0; unsigned char* y1; LAS unsigned char* meta;
    __device__ __forceinline__ void begin(const Unit& u, LAS unsigned char*) const {
        if (threadIdx.x < 256) ((LAS int*)(meta + (u.ui & 1) * 1024))[threadIdx.x] = rowtok[(size_t)u.e * NTOK + u.pm * 256 + min((int)threadIdx.x, u.cnt - 1)];
    }
    __device__ __forceinline__ void operator()(ACC_T, const Unit& u, int wr, int wc, int fr, int fq) const {
        const LAS int* mt = (const LAS int*)(meta + (u.ui & 1) * 1024);
        const float sc = 1.0f / SD8;
#pragma unroll
        for (int ai = 0; ai < 2; ++ai)
#pragma unroll
            for (int m = 0; m < 4; ++m) { const int rl = ai * HALF + wr * 64 + m * 16 + fr;
                if (rl < u.cnt) { const int tk = mt[rl]; unsigned char* rowp = ((tk & 1) ? y1 : y0) + (size_t)(tk >> 1) * DM + u.pn * BM + wc * 32 + 8 * fq;
#pragma unroll
                    for (int bj = 0; bj < 2; ++bj) { const f32x4 v0 = acc[ai][bj][m][0] * sc, v1 = acc[ai][bj][m][1] * sc;
                        *(u32x2*)(rowp + bj * HALF) = (u32x2){pk4_fp8(v0[0], v0[1], v0[2], v0[3]), pk4_fp8(v1[0], v1[1], v1[2], v1[3])}; } } }
    }
};
#undef ACC_T
}

namespace att {
typedef short v4i16_t __attribute__((ext_vector_type(4)));
__device__ __forceinline__ s16x4 vtr(const LAS char* p) { return __builtin_bit_cast(s16x4, __builtin_amdgcn_ds_read_tr16_b64_v4i16((LAS v4i16_t*)p)); }
__device__ __forceinline__ bf16x8 vfrag(const LAS char* p) { const s16x4 lo = vtr(p), hi = vtr(p + 512); return (bf16x8){lo[0], lo[1], lo[2], lo[3], hi[0], hi[1], hi[2], hi[3]}; }
__device__ __forceinline__ bf16x8 pfrag(const f32x16& p, int b) {
    u32x4 w; w.x = cvt_pk_bf16(p[b], p[b + 1]); w.y = cvt_pk_bf16(p[b + 2], p[b + 3]); w.z = cvt_pk_bf16(p[b + 4], p[b + 5]); w.w = cvt_pk_bf16(p[b + 6], p[b + 7]); return __builtin_bit_cast(bf16x8, w); }

__device__ __forceinline__ void glds16(const void* gsrc, unsigned lds_dst) { unsigned keep;
    asm volatile("s_mov_b32 %0, m0\n\ts_mov_b32 m0, %2\n\ts_nop 0\n\tglobal_load_lds_dwordx4 %1, off\n\ts_mov_b32 m0, %0" : "=&s"(keep) : "v"(gsrc), "s"(lds_dst) : "memory"); }
#define WAIT_BAR(N) asm volatile("s_waitcnt vmcnt(" #N ") lgkmcnt(0)\n\ts_barrier" ::: "memory")
#define MX3(a, b, c) __builtin_fmaxf(__builtin_fmaxf((a), (b)), (c))
__device__ __forceinline__ float fadd_s(float a, float b) { float r; asm("v_add_f32_e32 %0, %1, %2" : "=v"(r) : "v"(a), "v"(b)); return r; }
constexpr float THR = 8.0f, PZERO = -151.0f;

template <int NDB>
__device__ __forceinline__ void tile64(const LAS char* kbuf, const LAS char* vbuf, const int (&koff)[4], const bf16x8 (&qr)[4], float slope2, float u, float s32,
                                       bool causal, int kvrel0, int qrel, float& mref, float& l, f32x16 (&o)[NDB], LAS float* wsf, int r32, int hi, int lane) {
    bf16x8 kf[8];
#pragma unroll
    for (int s = 0; s < 4; ++s) { kf[2 * s] = *(const LAS bf16x8*)(kbuf + koff[s]); kf[2 * s + 1] = *(const LAS bf16x8*)(kbuf + koff[s] + 4096); }
    f32x16 p0, p1;
    { const float u0 = __builtin_fmaf(slope2, (float)(4 * hi), u), u1 = u0 + s32;
#pragma unroll
      for (int r = 0; r < 16; ++r) { const float cr = (float)((r & 3) + 8 * (r >> 2)); p0[r] = __builtin_fmaf(slope2, cr, u0); p1[r] = __builtin_fmaf(slope2, cr, u1); } }
    __builtin_amdgcn_sched_barrier(0);
#pragma unroll
    for (int s = 0; s < 4; ++s) {
        p0 = __builtin_amdgcn_mfma_f32_32x32x16_bf16(kf[2 * s], qr[s], p0, 0, 0, 0);
        p1 = __builtin_amdgcn_mfma_f32_32x32x16_bf16(kf[2 * s + 1], qr[s], p1, 0, 0, 0);
    }
    const LAS char* vp = vbuf + ((lane >> 4) & 1) * 32 + (lane & 3) * 8 + (4 * hi + ((lane & 15) >> 2)) * 64;
    bf16x8 vf[NDB][4];
#pragma unroll
    for (int ks = 0; ks < 4; ++ks) vf[0][ks] = vfrag(vp + ks * 1024);
    __builtin_amdgcn_sched_barrier(0);
    if (causal) {
#pragma unroll
        for (int r = 0; r < 16; ++r) { const int kv = kvrel0 + crow(r, hi); if (kv > qrel) p0[r] = -INFINITY; if (kv + 32 > qrel) p1[r] = -INFINITY; }
    }
    float ra = MX3(p0[0], p0[1], p1[0]), rb = MX3(p0[2], p0[3], p1[1]); ra = MX3(ra, p1[2], p1[3]);
#pragma unroll
    for (int r = 4; r < 16; r += 4) { ra = MX3(ra, p0[r], p0[r + 1]); rb = MX3(rb, p0[r + 2], p0[r + 3]); ra = MX3(ra, p1[r], p1[r + 1]); rb = MX3(rb, p1[r + 2], p1[r + 3]); }
    const float rm = xhalf_max(fmaxf(ra, rb));
    if (__all(rm < PZERO)) return;
    if (__any(rm > THR)) {
        const float dl = fmaxf(rm, 0.f); mref += dl;
#pragma unroll
        for (int r = 0; r < 16; ++r) { p0[r] -= dl; p1[r] -= dl; }
        const float f = __builtin_amdgcn_exp2f(-dl); l *= f;
        if (hi == 0) wsf[r32] = f;
        LDS_WAIT();
#pragma unroll
        for (int r = 0; r < 16; ++r) { const float fr_ = wsf[crow(r, hi)];
#pragma unroll
            for (int d = 0; d < NDB; ++d) o[d][r] *= fr_; }
    }
    {
    float sum = 0.f;
#pragma unroll
    for (int r = 0; r < 16; ++r) { p0[r] = __builtin_amdgcn_exp2f(p0[r]); p1[r] = __builtin_amdgcn_exp2f(p1[r]); }
    asm volatile("s_nop 1" : "+v"(p0), "+v"(p1));
    float sb = 0.f;
#pragma unroll
    for (int r = 0; r < 16; ++r) { sum = fadd_s(sum, p0[r]); sb = fadd_s(sb, p1[r]); }
    l += sum + sb; }
    const bf16x8 pa0 = pfrag(p0, 0), pa1 = pfrag(p0, 8), pa2 = pfrag(p1, 0), pa3 = pfrag(p1, 8);
    __builtin_amdgcn_sched_barrier(0);
#pragma unroll
    for (int d = 0; d < NDB; ++d) {
        if (d + 1 < NDB) {
#pragma unroll
            for (int ks = 0; ks < 4; ++ks) vf[d + 1][ks] = vfrag(vp + (d + 1) * 4096 + ks * 1024);
        }
        __builtin_amdgcn_sched_barrier(0);
        o[d] = __builtin_amdgcn_mfma_f32_32x32x16_bf16(pa0, vf[d][0], o[d], 0, 0, 0);
        o[d] = __builtin_amdgcn_mfma_f32_32x32x16_bf16(pa1, vf[d][1], o[d], 0, 0, 0);
        o[d] = __builtin_amdgcn_mfma_f32_32x32x16_bf16(pa2, vf[d][2], o[d], 0, 0, 0);
        o[d] = __builtin_amdgcn_mfma_f32_32x32x16_bf16(pa3, vf[d][3], o[d], 0, 0, 0);
        __builtin_amdgcn_sched_barrier(0);
    }
}

__device__ __forceinline__ void moba_unit(const bf16_t* __restrict__ proj, const LAS float* ksl, bf16_t* __restrict__ mixed, float* __restrict__ ssqA,
                                          int b, int h, int own, LAS char* lds, LAS float* wsf_all) {
    const int tid = threadIdx.x, lane = tid & 63, r32 = lane & 31, hi = lane >> 5, w = __builtin_amdgcn_readfirstlane(tid >> 6);
    LAS float* wsf = wsf_all + w * 64;
    const unsigned lds0 = (unsigned)(size_t)lds;
    const size_t rowb = (size_t)b * SEQ; const int q0 = own * 256;
    const int NT = 4 * (own + 1);
    const int krow = 8 * w + (lane >> 3);
    const bf16_t* hb = proj + ((size_t)(b * 8 + h) * SEQ) * 64;
    const bf16_t* ksrc = hb + pg8::PREG + krow * 64 + (((lane & 7) ^ ((krow >> 1) & 7)) << 3);
    const bf16_t* vsrc = hb + 2 * pg8::PREG + (16 * (w & 3) + (lane >> 2)) * 64 + (w >> 2) * 32 + (lane & 3) * 8;
    const unsigned dst0 = lds0 + w * 1024;
#define MOBA_DMA(s_) do { const int T_ = NT - 1 - (s_); const unsigned d_ = (unsigned)__builtin_amdgcn_readfirstlane(dst0 + ((s_) & 3) * 16384); \
        glds16(ksrc + T_ * 4096, d_); glds16(vsrc + T_ * 4096, d_ + 8192); } while (0)
    MOBA_DMA(0); MOBA_DMA(1); MOBA_DMA(2);
    const bf16_t* Qp = hb + (q0 + 32 * w + r32) * 64;
    bf16x8 qr[4];
#pragma unroll
    for (int s = 0; s < 4; ++s) qr[s] = *(const bf16x8*)(Qp + 16 * s + 8 * hi);
#pragma unroll
    for (int s = 0; s < 4; ++s) asm volatile("" : "+v"(qr[s]));
    int selmask = 0xff;
    if (own > 3) {
        float t1 = -INFINITY, t2 = -INFINITY, t3 = -INFINITY; int i1 = 0, i2 = 0, i3 = 0;
#pragma unroll 1
        for (int n = 0; n < own; ++n) {
            const LAS float* k0 = ksl + n * 64 + 8 * hi;
            float a = 0.f;
#pragma unroll
            for (int s = 0; s < 4; ++s) {
                const f32x4 x0 = *(const LAS f32x4*)(k0 + 16 * s), x1 = *(const LAS f32x4*)(k0 + 16 * s + 4);
                const u32x4 qq = __builtin_bit_cast(u32x4, qr[s]);
                a += bf_lo(qq.x) * x0[0] + bf_hi(qq.x) * x0[1] + bf_lo(qq.y) * x0[2] + bf_hi(qq.y) * x0[3] + bf_lo(qq.z) * x1[0] + bf_hi(qq.z) * x1[1] + bf_lo(qq.w) * x1[2] + bf_hi(qq.w) * x1[3];
            }
            a = xhalf_sum(a);
            const bool g1 = a > t1, g2 = a > t2, g3 = a > t3;
            t3 = g2 ? t2 : (g3 ? a : t3); i3 = g2 ? i2 : (g3 ? n : i3);
            t2 = g1 ? t1 : (g2 ? a : t2); i2 = g1 ? i1 : (g2 ? n : i2);
            t1 = g1 ? a : t1;             i1 = g1 ? n : i1;
        }
        selmask = (1 << i1) | (1 << i2) | (1 << i3);
    }
    const float slope2 = __builtin_amdgcn_exp2f(-(float)(h + 1)) * LOG2E;
    int koff[4];
#pragma unroll
    for (int s = 0; s < 4; ++s) koff[s] = r32 * 128 + (((2 * s + hi) ^ ((r32 >> 1) & 7)) << 4);
    float mref = 0.f, l = 0.f; f32x16 o[2]; o[0] = f32x16{}; o[1] = f32x16{};
    const int qrel = 32 * w + r32;
    for (int s = 0; s < NT; ++s) {
        const int T = NT - 1 - s, rem = NT - 1 - s;
        if (rem >= 2) WAIT_BAR(4); else if (rem == 1) WAIT_BAR(2); else WAIT_BAR(0);
        if (s + 3 < NT) MOBA_DMA(s + 3);
        const int jb = T - 4 * own;
        const bool skip = jb >= 0 && (64 * jb > 32 * w + 31);
        if (!skip) {
            const LAS char* buf = lds + (s & 3) * 16384;
            const bool sel = jb >= 0 || ((selmask >> (T >> 2)) & 1);
            const float u = sel ? (slope2 * (float)(64 * T - q0 - qrel) - mref) : -INFINITY;
            tile64<2>(buf, buf + 8192, koff, qr, slope2, u, 32.f * slope2, jb >= 0 && (64 * jb + 63 > 32 * w), 64 * jb, qrel, mref, l, o, wsf, r32, hi, lane);
        }
    }
#undef MOBA_DMA
    WAIT_BAR(0);
    l = xhalf_sum(l);
    if (hi == 0) wsf[32 + r32] = 1.0f / l;
    LDS_WAIT();
    LAS float* stg = (LAS float*)(lds + w * 8704);
#pragma unroll
    for (int r = 0; r < 16; ++r) { const int orow = crow(r, hi); const float il = wsf[32 + orow];
        stg[orow * 68 + r32] = o[0][r] * il; stg[orow * 68 + 32 + r32] = o[1][r] * il; }
    LDS_WAIT();
#pragma unroll
    for (int i = 0; i < 4; ++i) { const int row = 8 * i + (lane >> 3), ch = lane & 7; const LAS float* sp = stg + row * 68 + ch * 8;
      const f32x4 v0 = *(const LAS f32x4*)sp, v1 = *(const LAS f32x4*)(sp + 4);
      float q = (v0[0] * v0[0] + v0[1] * v0[1]) + (v0[2] * v0[2] + v0[3] * v0[3]) + (v1[0] * v1[0] + v1[1] * v1[1]) + (v1[2] * v1[2] + v1[3] * v1[3]);
      q += __shfl_xor(q, 1); q += __shfl_xor(q, 2); q += __shfl_xor(q, 4);
      const size_t grow = rowb + q0 + 32 * w + row;
      if (ch == 0) ssqA[grow * 8 + h] = q;
      *(u32x4*)(mixed + grow * DM + h * 64 + ch * 8) = pg8::pack8(v0, v1); }
    asm volatile("s_waitcnt lgkmcnt(0)\n\ts_barrier" ::: "memory");
}

__device__ __forceinline__ void diff_unit(const bf16_t* __restrict__ proj, bf16_t* __restrict__ mixed, const float* __restrict__ subln, float lam,
                                          int b, int h, int qt, LAS char* lds, LAS float* wsf_all) {
    const int tid = threadIdx.x, lane = tid & 63, r32 = lane & 31, hi = lane >> 5, w = __builtin_amdgcn_readfirstlane(tid >> 6), c = w >> 2, rg = w & 3;
    LAS float* wsf = wsf_all + w * 64;
    const unsigned lds0 = (unsigned)(size_t)lds;
    const size_t rowb = (size_t)b * SEQ; const int q0 = qt * 128;
    const int NT = 2 * (qt + 1);
    const int krow = 8 * w + (lane >> 3);
    const bf16_t* hb = proj + ((size_t)(b * 4 + h) * SEQ) * 128;
    const bf16_t* k0src = hb + 4 * pg8::PREG + krow * 64 + (((lane & 7) ^ ((krow >> 1) & 7)) << 3);
    const bf16_t* v0src = hb + 5 * pg8::PREG + (16 * (w & 3) + (lane >> 2)) * 128 + (w >> 2) * 32 + (lane & 3) * 8;
    const unsigned dst0 = lds0 + w * 1024;
#define DIFF_DMA(s_) do { const int T_ = NT - 1 - (s_); const unsigned d_ = (unsigned)__builtin_amdgcn_readfirstlane(dst0 + ((s_) & 3) * 32768); \
        glds16(k0src + T_ * 4096, d_); glds16(k0src + SEQ * 64 + T_ * 4096, d_ + 8192); glds16(v0src + T_ * 8192, d_ + 16384); glds16(v0src + 64 + T_ * 8192, d_ + 24576); } while (0)
    DIFF_DMA(0); DIFF_DMA(1); if (NT > 2) DIFF_DMA(2);
    const bf16_t* Qp = hb + 3 * pg8::PREG + (size_t)c * (SEQ * 64) + (q0 + 32 * rg + r32) * 64;
    bf16x8 qr[4];
#pragma unroll
    for (int s = 0; s < 4; ++s) qr[s] = *(const bf16x8*)(Qp + 16 * s + 8 * hi);
#pragma unroll
    for (int s = 0; s < 4; ++s) asm volatile("" : "+v"(qr[s]));
    const float slope2 = __builtin_amdgcn_exp2f(-2.0f * (float)(h + 1)) * LOG2E;
    int koff[4];
#pragma unroll
    for (int s = 0; s < 4; ++s) koff[s] = r32 * 128 + (((2 * s + hi) ^ ((r32 >> 1) & 7)) << 4);
    float mref = 0.f, l = 0.f; f32x16 o[4];
#pragma unroll
    for (int d = 0; d < 4; ++d) o[d] = f32x16{};
    const int qrel = 32 * rg + r32;
    for (int s = 0; s < NT; ++s) {
        const int T = NT - 1 - s, rem = NT - 1 - s;
        if (rem >= 2) WAIT_BAR(8); else if (rem == 1) WAIT_BAR(4); else WAIT_BAR(0);
        if (s + 3 < NT) DIFF_DMA(s + 3);
        const int jb = T - 2 * qt;
        const bool skip = jb >= 0 && (64 * jb > 32 * rg + 31);
        if (!skip) {
            const LAS char* buf = lds + (s & 3) * 32768;
            const float u = slope2 * (float)(64 * T - q0 - qrel) - mref;
            tile64<4>(buf + c * 8192, buf + 16384, koff, qr, slope2, u, 32.f * slope2, jb >= 0 && (64 * jb + 63 > 32 * rg), 64 * jb, qrel, mref, l, o, wsf, r32, hi, lane);
        }
    }
#undef DIFF_DMA
    WAIT_BAR(0);
    l = xhalf_sum(l);
    if (hi == 0) wsf[32 + r32] = (c == 1 ? lam : 1.0f) / l;
    LDS_WAIT();
    LAS float* Lb = (LAS float*)lds;
    if (c == 1) {
#pragma unroll
        for (int r = 0; r < 16; ++r) { const int orow = 32 * rg + crow(r, hi); const float il = wsf[32 + crow(r, hi)];
#pragma unroll
            for (int d = 0; d < 4; ++d) Lb[orow * 132 + 32 * d + r32] = o[d][r] * il; }
    }
    WAIT_BAR(0);
    if (c == 0) {
#pragma unroll
        for (int r = 0; r < 16; ++r) { const int orow = 32 * rg + crow(r, hi); const float il = wsf[32 + crow(r, hi)];
#pragma unroll
            for (int d = 0; d < 4; ++d) { const float v = o[d][r] * il - Lb[orow * 132 + 32 * d + r32]; Lb[orow * 132 + 32 * d + r32] = v; } }
    }
    WAIT_BAR(0);
    { const int ch = tid & 15; const f32x4 g0 = *(const f32x4*)(subln + ch * 8), g1 = *(const f32x4*)(subln + ch * 8 + 4);
#pragma unroll
      for (int i = 0; i < 4; ++i) { const int row = (tid >> 4) + 32 * i; const LAS float* sp = Lb + row * 132 + ch * 8;
        const f32x4 v0 = *(const LAS f32x4*)sp, v1 = *(const LAS f32x4*)(sp + 4);
        float q = (v0[0] * v0[0] + v0[1] * v0[1]) + (v0[2] * v0[2] + v0[3] * v0[3]) + (v1[0] * v1[0] + v1[1] * v1[1]) + (v1[2] * v1[2] + v1[3] * v1[3]);
        q += __shfl_xor(q, 1); q += __shfl_xor(q, 2); q += __shfl_xor(q, 4); q += __shfl_xor(q, 8);
        const float rs = 0.8f / sqrtf(q * (1.0f / 128.0f) + RMS_EPS);
        *(u32x4*)(mixed + (rowb + q0 + row) * DM + 512 + h * 128 + ch * 8) = pg8::pack8(v0 * g0 * rs, v1 * g1 * rs); } }
    asm volatile("s_waitcnt lgkmcnt(0)\n\ts_barrier" ::: "memory");
}

__device__ __forceinline__ void cross_unit(const bf16_t* __restrict__ qmem, const bf16_t* __restrict__ kvmem, unsigned char* __restrict__ omem, int b, int mh, int qt, LAS char* lds, LAS float* wsf_all) {
    const int tid = threadIdx.x, lane = tid & 63, r32 = lane & 31, hi = lane >> 5, w = __builtin_amdgcn_readfirstlane(tid >> 6);
    LAS float* wsf = wsf_all + w * 64;
    const unsigned lds0 = (unsigned)(size_t)lds;
    const size_t qrow = (size_t)b * SEQ + qt * 256 + 32 * w + r32;
    const bf16_t* Qp = qmem + qrow * DM + mh * 256;
    const bf16_t* kbase = kvmem + (size_t)b * MEMLEN * 2048 + mh * 256;
    const bf16_t* ksrc0; { const int row = 2 * w + (lane >> 5); ksrc0 = kbase + (size_t)row * 2048 + (((lane & 31) ^ (row & 15)) << 3); }
    const bf16_t* vsrc = kbase + 1024 + (size_t)(16 * (w & 3) + (lane >> 2)) * 2048 + (w >> 2) * 32 + (lane & 3) * 8;
    const unsigned dst0 = lds0 + w * 1024;
#define CROSS_DMA(st_) do { const unsigned d_ = (unsigned)__builtin_amdgcn_readfirstlane(dst0 + ((st_) & 3) * 32768); \
        if ((st_) < 4) { _Pragma("unroll") for (int j_ = 0; j_ < 4; ++j_) glds16(ksrc0 + (size_t)((st_) * 64 + 16 * j_) * 2048, d_ + j_ * 8192); } \
        else { _Pragma("unroll") for (int j_ = 0; j_ < 4; ++j_) glds16(vsrc + (size_t)((st_) - 4) * 64 * 2048 + j_ * 64, d_ + j_ * 8192); } } while (0)
    CROSS_DMA(0); CROSS_DMA(1); CROSS_DMA(2);
    bf16x8 qr[16];
#pragma unroll
    for (int s = 0; s < 16; ++s) qr[s] = *(const bf16x8*)(Qp + 16 * s + 8 * hi);
#pragma unroll
    for (int s = 0; s < 16; ++s) asm volatile("" : "+v"(qr[s]));
    int koff[8];
#pragma unroll
    for (int s = 0; s < 8; ++s) koff[s] = r32 * 512 + (((2 * s + hi) ^ (r32 & 15)) << 4);
    f32x16 p[8];
#pragma unroll
    for (int kt = 0; kt < 4; ++kt) {
        WAIT_BAR(8);
        CROSS_DMA(kt + 3);
        const LAS char* kp = lds + (kt & 3) * 32768;
        f32x16 a0 = f32x16{}, a1 = f32x16{};
#pragma unroll
        for (int s = 0; s < 16; ++s) {
            const bf16x8 k0 = *(const LAS bf16x8*)(kp + koff[s & 7] + (s >> 3) * 256), k1 = *(const LAS bf16x8*)(kp + koff[s & 7] + (s >> 3) * 256 + 16384);
            a0 = __builtin_amdgcn_mfma_f32_32x32x16_bf16(k0, qr[s], a0, 0, 0, 0);
            a1 = __builtin_amdgcn_mfma_f32_32x32x16_bf16(k1, qr[s], a1, 0, 0, 0);
            if ((s & 3) == 3) __builtin_amdgcn_sched_barrier(0);
        }
        p[2 * kt] = a0; p[2 * kt + 1] = a1;
    }
    float m = p[0][0];
#pragma unroll
    for (int i = 0; i < 8; ++i)
#pragma unroll
        for (int r = 0; r < 16; ++r) m = fmaxf(m, p[i][r]);
    m = xhalf_max(m);
    float l = 0.f;
#pragma unroll
    for (int i = 0; i < 8; ++i)
#pragma unroll
        for (int r = 0; r < 16; ++r) { p[i][r] = __builtin_amdgcn_exp2f(p[i][r] - m); l += p[i][r]; }
    l = xhalf_sum(l);
    bf16x8 pa[16];
#pragma unroll
    for (int i = 0; i < 8; ++i) { pa[2 * i] = pfrag(p[i], 0); pa[2 * i + 1] = pfrag(p[i], 8); }
    f32x16 o[8];
#pragma unroll
    for (int d = 0; d < 8; ++d) o[d] = f32x16{};
    const int vlane = ((lane >> 4) & 1) * 32 + (lane & 3) * 8 + (4 * hi + ((lane & 15) >> 2)) * 64;
#pragma unroll
    for (int vt = 0; vt < 4; ++vt) {
        if (vt == 0) { WAIT_BAR(8); CROSS_DMA(7); } else if (vt == 1) WAIT_BAR(8); else if (vt == 2) WAIT_BAR(4); else WAIT_BAR(0);
        const LAS char* vp = lds + ((4 + vt) & 3) * 32768 + vlane;
#pragma unroll
        for (int d = 0; d < 8; ++d) {
#pragma unroll
            for (int ks = 0; ks < 4; ++ks) o[d] = __builtin_amdgcn_mfma_f32_32x32x16_bf16(pa[4 * vt + ks], vfrag(vp + d * 4096 + ks * 1024), o[d], 0, 0, 0);
            if (d & 1) __builtin_amdgcn_sched_barrier(0);
        }
    }
#undef CROSS_DMA
    WAIT_BAR(0);
    if (hi == 0) wsf[32 + r32] = 1.0f / l;
    LDS_WAIT();
    LAS unsigned short* stg = (LAS unsigned short*)(lds + w * 8704);
    float il[16];
#pragma unroll
    for (int r = 0; r < 16; ++r) il[r] = wsf[32 + crow(r, hi)];
#pragma unroll
    for (int hf = 0; hf < 2; ++hf) {
#pragma unroll
        for (int r = 0; r < 16; ++r) { const int orow = crow(r, hi);
#pragma unroll
            for (int d = 0; d < 4; ++d) stg[orow * 136 + 32 * d + r32] = (unsigned short)(cvt_pk_bf16(o[4 * hf + d][r] * il[r], 0.f) & 0xffffu); }
        LDS_WAIT();
#pragma unroll
        for (int i = 0; i < 8; ++i) { const int row = (lane >> 4) + 4 * i, ch = lane & 15;
          const u32x4 ob = *(const LAS u32x4*)(stg + row * 136 + ch * 8);
          *(u32x2*)(omem + ((size_t)b * SEQ + qt * 256 + 32 * w + row) * DM + mh * 256 + hf * 128 + ch * 8) =
              (u32x2){pk4_fp8(bf_lo(ob.x) * SH8, bf_hi(ob.x) * SH8, bf_lo(ob.y) * SH8, bf_hi(ob.y) * SH8), pk4_fp8(bf_lo(ob.z) * SH8, bf_hi(ob.z) * SH8, bf_lo(ob.w) * SH8, bf_hi(ob.w) * SH8)}; }
        LDS_WAIT();
    }
    asm volatile("s_waitcnt lgkmcnt(0)\n\ts_barrier" ::: "memory");
}
}

typedef GAS unsigned gu32;
#define RLX_AGENT __ATOMIC_RELAXED, __HIP_MEMORY_SCOPE_AGENT
#define XB_TMO      128
#define XB_XCNT(j)  (256  + 64 * (j))
#define XB_XSUB(j)  (1280 + 64 * (j))
#define XB_XGEN(j)  (2304 + 64 * (j))
#define XB_TOP      3328
#define XB_TOPGEN   3392
#define XCD_BAR_WORDS 3456
#define XB_SPIN_CAP (1u << 18)
__device__ __forceinline__ unsigned xb_ld(unsigned* p)              { return __hip_atomic_load(p, __ATOMIC_RELAXED, __HIP_MEMORY_SCOPE_AGENT); }
__device__ __forceinline__ unsigned xb_add(unsigned* p, unsigned v) { return __hip_atomic_fetch_add(p, v, __ATOMIC_RELAXED, __HIP_MEMORY_SCOPE_AGENT); }
__device__ __forceinline__ unsigned xb_xcc_id() { return (unsigned)__builtin_amdgcn_s_getreg((3 << 11) | 20) & 0xFu; }
#define XB_SPIN(cond, bar) do { unsigned _sp = 0; while (cond) { __builtin_amdgcn_s_sleep(1); \
    if ((++_sp & 255u) == 0u) { if (xb_ld(&(bar)[XB_TMO])) break; if (_sp > XB_SPIN_CAP) { atomicAdd(&(bar)[XB_TMO], 1u); break; } } } } while (0)
struct XcdBarrier { unsigned* bar; unsigned x; volatile LAS unsigned* st; };
__device__ __forceinline__ XcdBarrier xcd_barrier_post(unsigned* bar, volatile LAS unsigned* st) {
    XcdBarrier b; b.bar = bar; b.x = xb_xcc_id(); b.st = st;
    if (threadIdx.x == 0) (void)xb_add(&bar[XB_XCNT(b.x)], 1u);
    return b;
}
__device__ __forceinline__ void xcd_barrier_complete(unsigned* bar, unsigned x, unsigned& nloc, unsigned& nx) {
    const unsigned G = gridDim.x * gridDim.y * gridDim.z;
    unsigned sum, cnt, mine, sp = 0u;
    for (;;) {
        sum = 0u; cnt = 0u; mine = 0u;
#pragma unroll
        for (unsigned j = 0; j < 16; ++j) { const unsigned c = xb_ld(&bar[XB_XCNT(j)]); sum += c; cnt += (c > 0u) ? 1u : 0u; mine = (j == x) ? c : mine; }
        if (sum == G) break;
        __builtin_amdgcn_s_sleep(1);
        if ((++sp & 255u) == 0u) { if (xb_ld(&bar[XB_TMO])) break; if (sp > XB_SPIN_CAP) { atomicAdd(&bar[XB_TMO], 1u); break; } }
    }
    nloc = mine > 0u ? mine : 1u; nx = cnt > 0u ? cnt : 1u;
}
__device__ __forceinline__ void xcd_barrier(const XcdBarrier& b) {
    asm volatile("s_waitcnt vmcnt(0)" ::: "memory");
    __syncthreads();
    if (threadIdx.x == 0) {
        unsigned* bar = b.bar;
        __builtin_amdgcn_s_waitcnt(0);
        unsigned nloc = b.st[0], nx = b.st[1];
        if (nloc == 0u) { xcd_barrier_complete(bar, b.x, nloc, nx); b.st[0] = nloc; b.st[1] = nx; }
        const unsigned old = xb_add(&bar[XB_XSUB(b.x)], 1u);
        const unsigned gen = old / nloc;
        if (old + 1u == (gen + 1u) * nloc) {
            __builtin_amdgcn_fence(__ATOMIC_RELEASE, "agent");
            asm volatile("s_waitcnt vmcnt(0)" ::: "memory");
            const unsigned og = xb_add(&bar[XB_TOP], 1u);
            const unsigned tg = og / nx;
            if (og + 1u == (tg + 1u) * nx) xb_add(&bar[XB_TOPGEN], 1u);
            else XB_SPIN(xb_ld(&bar[XB_TOPGEN]) == tg, bar);
            __builtin_amdgcn_fence(__ATOMIC_ACQUIRE, "agent");
            xb_add(&bar[XB_XGEN(b.x)], 1u);
            asm volatile("s_waitcnt vmcnt(0)" ::: "memory");
        } else {
            XB_SPIN(xb_ld(&bar[XB_XGEN(b.x)]) == gen, bar);
            __builtin_amdgcn_fence(__ATOMIC_ACQUIRE, "agent");
            asm volatile("s_waitcnt vmcnt(0)" ::: "memory");
        }
    }
    __syncthreads();
}

constexpr int NWAVES = 8;
__device__ __forceinline__ void p0_transpose_item(const float* W, int K, int N, bf16_t* WT, int rmode, const float* gain, int gain_n, LAS float* scr, int item, int lane) {
    const int nblk = N / 32, kb = item / nblk, nb = item % nblk, k0 = 64 * kb, n0 = 32 * nb;
#pragma unroll 8
    for (int i = 0; i < 32; ++i) { const int kk = 2 * i + (lane >> 5); float v = W[(size_t)(k0 + kk) * N + n0 + (lane & 31)]; if (gain && (k0 + kk) < gain_n) v *= gain[k0 + kk]; scr[kk * 33 + (lane & 31)] = v; }
    LDS_WAIT(); asm volatile("" ::: "memory");
    const int c = lane & 7;
#pragma unroll
    for (int j = 0; j < 4; ++j) { const int n = (lane >> 3) + 8 * j; const LAS float* s = scr + (8 * c) * 33 + n;
        u32x4 o; o.x = cvt_pk_bf16(s[0 * 33], s[1 * 33]); o.y = cvt_pk_bf16(s[2 * 33], s[3 * 33]); o.z = cvt_pk_bf16(s[4 * 33], s[5 * 33]); o.w = cvt_pk_bf16(s[6 * 33], s[7 * 33]);
        const int nn = n0 + n; const int row = rmode == 0 ? nn : ((nn >> 7) * 256 + (nn & 127) + (rmode == 2 ? 128 : 0));
        *(u32x4*)(WT + (size_t)row * K + k0 + 8 * c) = o; }
    LDS_WAIT(); asm volatile("" ::: "memory");
}
__device__ __forceinline__ void p0_transpose_item8(const float* W, int K, int N, unsigned char* WT, int rmode, const float* gain, float scale, LAS float* scr, int item, int lane) {
    const int nblk = N / 32, kb = item / nblk, nb = item % nblk, k0 = 64 * kb, n0 = 32 * nb;
#pragma unroll 8
    for (int i = 0; i < 32; ++i) { const int kk = 2 * i + (lane >> 5); float v = W[(size_t)(k0 + kk) * N + n0 + (lane & 31)] * scale; if (gain) v *= gain[k0 + kk]; scr[kk * 33 + (lane & 31)] = v; }
    LDS_WAIT(); asm volatile("" ::: "memory");
    const int c = lane & 7;
#pragma unroll
    for (int j = 0; j < 4; ++j) { const int n = (lane >> 3) + 8 * j; const LAS float* sp = scr + (8 * c) * 33 + n;
        const u32x2 o = (u32x2){pk4_fp8(sp[0 * 33], sp[1 * 33], sp[2 * 33], sp[3 * 33]), pk4_fp8(sp[4 * 33], sp[5 * 33], sp[6 * 33], sp[7 * 33])};
        const int nn = n0 + n; const int row = rmode == 0 ? nn : ((nn >> 7) * 256 + (nn & 127) + (rmode == 2 ? 128 : 0));
        *(u32x2*)(WT + (size_t)row * K + k0 + 8 * c) = o; }
    LDS_WAIT(); asm volatile("" ::: "memory");
}
__device__ __forceinline__ void rms_row_to_bf16(const float* xrow, const float* gain, bf16_t* orow, int lane, float* inv_out = nullptr) {
    const f32x4* xr = (const f32x4*)xrow + lane; const f32x4* gr = (const f32x4*)gain + lane;
    f32x4 v[4]; float s = 0.f;
#pragma unroll
    for (int j = 0; j < 4; ++j) { v[j] = xr[64 * j]; s += (v[j][0] * v[j][0] + v[j][1] * v[j][1]) + (v[j][2] * v[j][2] + v[j][3] * v[j][3]); }
    const float rms = sqrtf(wave_sum(s) * (1.0f / 1024.0f) + RMS_EPS), rstd = 1.0f / rms;
    if (inv_out && lane == 0) *inv_out = rms;
    u32x2* o8 = (u32x2*)orow + lane;
#pragma unroll
    for (int j = 0; j < 4; ++j) { const f32x4 g = gr[64 * j], y = v[j] * g * rstd; u32x2 o; o.x = cvt_pk_bf16(y[0], y[1]); o.y = cvt_pk_bf16(y[2], y[3]); o8[64 * j] = o; }
}

__device__ __forceinline__ void rms_row_to_fp8(const float* xrow, const float* gain, unsigned char* orow, int lane) {
    const f32x4* xr = (const f32x4*)xrow + lane; const f32x4* gr = (const f32x4*)gain + lane;
    f32x4 v[4]; float s = 0.f;
#pragma unroll
    for (int j = 0; j < 4; ++j) { v[j] = xr[64 * j]; s += (v[j][0] * v[j][0] + v[j][1] * v[j][1]) + (v[j][2] * v[j][2] + v[j][3] * v[j][3]); }
    const float rstd = 1.0f / sqrtf(wave_sum(s) * (1.0f / 1024.0f) + RMS_EPS);
    unsigned* o4 = (unsigned*)orow + lane;
#pragma unroll
    for (int j = 0; j < 4; ++j) { const f32x4 g = gr[64 * j], y = v[j] * g * rstd; o4[64 * j] = pk4_fp8(y[0], y[1], y[2], y[3]); }
}

struct Args { const float* in[25]; float* out; unsigned char* ws; int ph_lo, ph_hi; };
constexpr int NPHASE = 11;

__global__ void __launch_bounds__(NWAVES * 64, 2) hymba_fwd(Args args) {
    extern __shared__ __attribute__((aligned(16))) unsigned char lds_raw[];
    LAS unsigned char* lds = (LAS unsigned char*)lds_raw;
    volatile LAS unsigned* MISC = (volatile LAS unsigned*)(lds + MISC_OFF);
    LAS float* wsf_all = (LAS float*)(lds + MISC_OFF + 1024);
    LAS int* mtab = (LAS int*)(lds + MISC_OFF + 4096);
    const int tid = threadIdx.x, lane = tid & 63, wave = __builtin_amdgcn_readfirstlane(tid >> 6);
    const int G = gridDim.x; const int bx = blockIdx.x; const int vcu = (G % 8 == 0) ? (bx % 8) * (G / 8) + bx / 8 : bx;
    unsigned char* ws = args.ws;
    unsigned* ctl = (unsigned*)(ws + WS_CTL);
#pragma unroll
    for (int u = 0; u < (LDS_BYTES - MISC_OFF) / 16 / (NWAVES * 64); ++u) ((LAS u32x4*)(lds + MISC_OFF))[tid + u * NWAVES * 64] = (u32x4){0u, 0u, 0u, 0u};
    __syncthreads();
    XcdBarrier bar = xcd_barrier_post(ctl + CW_BAR, MISC + 8);
    const int lo = args.ph_lo, hi = args.ph_hi;
#ifndef PHMASK
#define PHMASK 0x7ff
#endif
#define IN(k) (((PHMASK >> (k)) & 1) && lo <= (k) && (k) < hi)
#define SEAM(k) do { if (IN(k) && IN((k) + 1)) xcd_barrier(bar); } while (0)
    const float* x = args.in[0]; const float* mem = args.in[1]; const float* norm_mix = args.in[2]; const float* w_in = args.in[3];
    const float* lq1 = args.in[4]; const float* lk1 = args.in[5]; const float* lq2 = args.in[6]; const float* lk2 = args.in[7];
    const float* diff_subln = args.in[8]; const float* norm_moba_out = args.in[9]; const float* w_out = args.in[10];
    const float* norm_mem_q = args.in[11]; const float* norm_mem_kv = args.in[12]; const float* w_mem_q = args.in[13]; const float* w_mem_kv = args.in[14]; const float* w_mem_o = args.in[15];
    const float* norm_ffn = args.in[16]; const float* w_rg = args.in[17]; const float* b_rg = args.in[18]; const float* w_re = args.in[19]; const float* b_re = args.in[20];
    const float* w_gate = args.in[21]; const float* w_up = args.in[22]; const float* w_down = args.in[23]; const float* norm_final = args.in[24];
    bf16_t* WinT = (bf16_t*)(ws + WS_WIN); bf16_t* WoutT = (bf16_t*)(ws + WS_WOUT); unsigned char* Wq8 = ws + WS_WQ; unsigned char* Wkv8 = ws + WS_WKV;
    unsigned char* Wo8 = ws + WS_WO; bf16_t* WrT = (bf16_t*)(ws + WS_WR); unsigned char* Wgu8 = ws + WS_WGU; unsigned char* Wd8 = ws + WS_WD;
    unsigned char* memn8 = ws + WS_MEMN; bf16_t* kvmem = (bf16_t*)(ws + WS_KVMEM);
    float* kms = (float*)(ws + WS_KMS); float* ssqA = (float*)(ws + WS_SSQA); float* ssq1 = (float*)(ws + WS_SSQ1); float* ssq2 = (float*)(ws + WS_SSQ2);
    int* rowtok = (int*)(ws + WS_ROWTOK); float* roww = (float*)(ws + WS_ROWW); float* rowrstd = (float*)(ws + WS_ROWRSTD);
    bf16_t* hn = (bf16_t*)(ws + WS_R0); bf16_t* mixed = (bf16_t*)(ws + WS_H2); float* invrx = (float*)(ws + WS_INVRX);
     unsigned char* y0 = ws + WS_R0 + 64 * MiB;
    bf16_t* h1 = (bf16_t*)(ws + WS_H1); unsigned char* y1 = ws + WS_H1; bf16_t* h2 = (bf16_t*)(ws + WS_H2);
    bf16_t* proj = (bf16_t*)(ws + WS_BIG); bf16_t* qmem = (bf16_t*)(ws + WS_QMEM); unsigned char* omem8 = ws + WS_OMEM; unsigned char* h1f8 = ws + WS_BIG + 256 * MiB; unsigned char* Hid8 = ws + WS_HID; unsigned char* h2f8 = ws + WS_R0;
    unsigned* ecnt = ctl + CW_ECNT;

    if (IN(0)) {
        LAS float* scr = (LAS float*)(lds + wave * 16384);
        const int gw = vcu * NWAVES + wave, NGW = G * NWAVES;
        constexpr int I_IN = 16 * 96, I_SQ = 16 * 32, I_KV = 16 * 64, I_GU = 16 * 16, I_DN = 8 * 32;
        constexpr int NITEMS = I_IN + 3 * I_SQ + I_KV + 32 + NEXP * (2 * I_GU + I_DN);
        for (int it = gw; it < NITEMS; it += NGW) {
            int r = it;
            if (r < I_IN) { p0_transpose_item(w_in, 1024, 3072, WinT, 0, nullptr, 0, scr, r, lane); continue; } r -= I_IN;
            if (r < I_SQ) { p0_transpose_item(w_out, 1024, 1024, WoutT, 0, norm_moba_out, 512, scr, r, lane); continue; } r -= I_SQ;
            if (r < I_SQ) { p0_transpose_item8(w_mem_q, 1024, 1024, Wq8, 0, norm_mem_q, SW8, scr, r, lane); continue; } r -= I_SQ;
            if (r < I_KV) { p0_transpose_item8(w_mem_kv, 1024, 2048, Wkv8, 0, nullptr, SW8, scr, r, lane); continue; } r -= I_KV;
            if (r < I_SQ) { p0_transpose_item8(w_mem_o, 1024, 1024, Wo8, 0, nullptr, SW8, scr, r, lane); continue; } r -= I_SQ;
            if (r < 32) {
                const int k0 = (r & 15) * 64;
                if (r < 16) { for (int n = 0; n < 4; ++n) { const int k = k0 + lane; WrT[(size_t)n * 1024 + k] = (bf16_t)(cvt_pk_bf16(w_rg[(size_t)k * 4 + n] * norm_ffn[k], 0.f) & 0xffffu); } }
                else { for (int n = 0; n < 32; ++n) { const int k = k0 + lane; WrT[(size_t)(4 + n) * 1024 + k] = (bf16_t)(cvt_pk_bf16(w_re[(size_t)k * 32 + n] * norm_ffn[k], 0.f) & 0xffffu); } }
                continue; } r -= 32;
            const int per = 2 * I_GU + I_DN, e = r / per; r -= e * per;
            if (r < I_GU) { p0_transpose_item8(w_gate + (size_t)e * 1024 * 512, 1024, 512, Wgu8 + (size_t)e * 1024 * 1024, 1, norm_ffn, SW8, scr, r, lane); continue; } r -= I_GU;
            if (r < I_GU) { p0_transpose_item8(w_up + (size_t)e * 1024 * 512, 1024, 512, Wgu8 + (size_t)e * 1024 * 1024, 2, norm_ffn, SW8, scr, r, lane); continue; } r -= I_GU;
            p0_transpose_item8(w_down + (size_t)e * 512 * 1024, 512, 1024, Wd8 + (size_t)e * 1024 * 512, 0, nullptr, SD8, scr, r, lane);
        }
        for (int mrow = gw; mrow < NTOK; mrow += NGW) rms_row_to_bf16(x + (size_t)mrow * DM, norm_mix, hn + (size_t)mrow * DM, lane, invrx + mrow);
        for (int mrow = gw; mrow < NMEMROW; mrow += NGW) rms_row_to_fp8(mem + (size_t)mrow * DM, norm_mem_kv, memn8 + (size_t)mrow * DM, lane);
        for (int i = gw * 64 + lane; i < (256 - 36) * 1024 / 8; i += NGW * 64) ((u32x4*)(WrT + 36 * 1024))[i] = (u32x4){0u, 0u, 0u, 0u};
    }
    SEAM(0);
    if (IN(1)) {
        { pg8::DenseOrder S; S.init(hn, WinT, NTOK, PROJW, DM, G, bx); pg8::EpiProj E{proj, kms};
          pg8::gemm_phase<pg8::EpiProj, pg8::DenseOrder, true, false, false>(lds, DM, S, E); }
        { pg8::DenseOrder S; S.init(memn8, Wkv8, NMEMROW, 2048, DM, G, bx, 1, true); pg8::EpiPlain E{kvmem, 2048, 1.0f / SW8};
          pg8::gemm_phase<pg8::EpiPlain, pg8::DenseOrder, true, true, false, true>(lds, DM, S, E); }
    }
    SEAM(1);
    if (IN(2)) {
        float lam;
        { const int ln = (int)__builtin_amdgcn_mbcnt_hi(~0u, __builtin_amdgcn_mbcnt_lo(~0u, 0u));
          const float a = wave_sum(lq1[ln] * lk1[ln]), c = wave_sum(lq2[ln] * lk2[ln]); lam = __expf(a) - __expf(c) + 0.2f; }
        for (int v = vcu; v < 256; v += G) { const int b = v >> 3, j = v & 7;
#pragma unroll 1
            for (int i = 0; i < 8; ++i) { const int h = i >> 1, s = (j + 2 * h) & 7; const int qt = (i & 1) ? 15 - s : s; att::diff_unit(proj, mixed, diff_subln, lam, b, h, qt, (LAS char*)lds, wsf_all); } }
        for (int v = vcu; v < 256; v += G) { const int b = v >> 3, j = v & 7;
            LAS float* ksl = (LAS float*)(lds + MISC_OFF + 6144);
            const size_t ko = ((size_t)(b * 8 + (tid >> 6))) * 512 + (tid & 63);
            float kn = kms[ko] + kms[ko + (size_t)256 * 512];
#pragma unroll 1
            for (int h = 0; h < 8; ++h) {
                ksl[tid] = kn; __syncthreads();
                if (h < 7) kn = kms[ko + (h + 1) * 64] + kms[ko + (h + 1) * 64 + (size_t)256 * 512];
                att::moba_unit(proj, ksl, mixed, ssqA, b, h, (j + h) & 7, (LAS char*)lds, wsf_all); } }
    }
    SEAM(2);
    if (IN(3)) {
        pg8::DenseOrder S; S.init(mixed, WoutT, NTOK, DM, DM, G, bx); pg8::EpiOut E{hn, invrx, norm_mix, ssqA, h1, ssq1, h1f8, lds + MISC_OFF + 16384};
        pg8::gemm_phase<pg8::EpiOut, pg8::DenseOrder, true, false, true>(lds, DM, S, E);
    }
    SEAM(3);
    if (IN(4)) {
        pg8::DenseOrder S; S.init(h1f8, Wq8, NTOK, DM, DM, G, bx, 1, true); pg8::EpiQ E{ssq1, qmem, lds + MISC_OFF};
        pg8::gemm_phase<pg8::EpiQ, pg8::DenseOrder, true, true, false, true>(lds, DM, S, E);
    }
    SEAM(4);
    if (IN(5)) {
        for (int u = vcu; u < 1024; u += G) { const int qt = u & 7, mh = (u >> 3) & 3, b = u >> 5; att::cross_unit(qmem, kvmem, omem8, b, mh, qt, (LAS char*)lds, wsf_all); }
    }
    SEAM(5);
    if (IN(6)) {
        pg8::DenseOrder S; S.init(omem8, Wo8, NTOK, DM, DM, G, bx, 1, true); pg8::EpiRes E{h1, h2, ssq2, h2f8, 1.0f / (SH8 * SW8)};
        pg8::gemm_phase<pg8::EpiRes, pg8::DenseOrder, true, true, false, true>(lds, DM, S, E);
    }
    SEAM(6);
    if (IN(7)) {
        pg8::DenseOrder S; S.init(h2, WrT, NTOK, 256, DM, G, bx); pg8::EpiRouter E{ssq2, b_rg, b_re, ecnt, rowtok, roww, rowrstd};
        pg8::gemm_phase<pg8::EpiRouter, pg8::DenseOrder, false, false, false>(lds, DM, S, E);
    }
    SEAM(7);
    if (IN(8) || IN(9)) {
        if (tid == 0) { int ub = 0, hb = 0;
            for (int e = 0; e < 32; ++e) { const int c = (int)__hip_atomic_load(ecnt + e, RLX_AGENT); const int nrt = (c + 255) >> 8; mtab[e] = c; mtab[32 + e] = ub; mtab[65 + e] = hb; ub += nrt * 4; hb += nrt * 256; }
            mtab[64] = ub; mtab[97] = hb; }
        __syncthreads();
        if (tid < 16) { const int L = tid * G + bx; int e = -1, rt = 0, pn = 0, cn = 0, r0 = 0;
            if (L < mtab[64]) { e = 0; for (int k = 1; k < 32; ++k) if (L >= mtab[32 + k]) e = k;
                const int within = L - mtab[32 + e]; rt = within >> 2; pn = within & 3; cn = min(256, mtab[e] - rt * 256); r0 = mtab[65 + e] + rt * 256; }
            mtab[128 + 8 * tid] = e; mtab[128 + 8 * tid + 1] = rt; mtab[128 + 8 * tid + 2] = pn; mtab[128 + 8 * tid + 3] = cn; mtab[128 + 8 * tid + 4] = r0; }
        __syncthreads();
    }
    if (IN(8)) {
        pg8::MoeOrder S{mtab, (const char*)h2f8, (const char*)Wgu8, rowtok, DM, G, bx, true, 1}; pg8::EpiUp E{roww, rowrstd, Hid8, lds + MISC_OFF + 16384};
        pg8::gemm_phase<pg8::EpiUp, pg8::MoeOrder, true, true, false, true>(lds, DM, S, E);
    }
    SEAM(8);
    if (IN(9)) {
        pg8::MoeOrder S{mtab, (const char*)Hid8, (const char*)Wd8, rowtok, EFF, G, bx, false, 1}; pg8::EpiDown E{rowtok, y0, y1, lds + MISC_OFF + 16384};
        pg8::gemm_phase<pg8::EpiDown, pg8::MoeOrder, true, true, false, true>(lds, EFF, S, E);
    }
    SEAM(9);
    if (IN(10)) {
        const bool dead = xb_ld(&bar.bar[XB_TMO]) != 0u;
        const int ln = (int)__builtin_amdgcn_mbcnt_hi(~0u, __builtin_amdgcn_mbcnt_lo(~0u, 0u));
        const int gw = vcu * NWAVES + wave, NGW = G * NWAVES;
        for (int row = gw; row < NTOK; row += NGW) {
            const size_t off = (size_t)row * DM + 8 * ln;
            f32x4 v[4]; float s = 0.f;
#pragma unroll
            for (int j = 0; j < 2; ++j) { const u32x4 a = *(const u32x4*)(h2 + off + 512 * j); const u32x2 b = *(const u32x2*)(y0 + off + 512 * j), c = *(const u32x2*)(y1 + off + 512 * j);
                const f32x2 b0 = __builtin_amdgcn_cvt_pk_f32_fp8((int)b.x, false), b1 = __builtin_amdgcn_cvt_pk_f32_fp8((int)b.x, true), b2 = __builtin_amdgcn_cvt_pk_f32_fp8((int)b.y, false), b3 = __builtin_amdgcn_cvt_pk_f32_fp8((int)b.y, true);
                const f32x2 c0 = __builtin_amdgcn_cvt_pk_f32_fp8((int)c.x, false), c1 = __builtin_amdgcn_cvt_pk_f32_fp8((int)c.x, true), c2 = __builtin_amdgcn_cvt_pk_f32_fp8((int)c.y, false), c3 = __builtin_amdgcn_cvt_pk_f32_fp8((int)c.y, true);
                const float ys = 1.0f / SH8;
                v[2 * j] = (f32x4){bf_lo(a.x) + (b0[0] + c0[0]) * ys, bf_hi(a.x) + (b0[1] + c0[1]) * ys, bf_lo(a.y) + (b1[0] + c1[0]) * ys, bf_hi(a.y) + (b1[1] + c1[1]) * ys};
                v[2 * j + 1] = (f32x4){bf_lo(a.z) + (b2[0] + c2[0]) * ys, bf_hi(a.z) + (b2[1] + c2[1]) * ys, bf_lo(a.w) + (b3[0] + c3[0]) * ys, bf_hi(a.w) + (b3[1] + c3[1]) * ys}; }
#pragma unroll
            for (int j = 0; j < 4; ++j) s += (v[j][0] * v[j][0] + v[j][1] * v[j][1]) + (v[j][2] * v[j][2] + v[j][3] * v[j][3]);
            float rstd = 1.0f / sqrtf(wave_sum(s) * (1.0f / 1024.0f) + RMS_EPS);
            if (dead) rstd = __builtin_nanf("");
#pragma unroll
            for (int j = 0; j < 2; ++j) { const f32x4 g0 = *(const f32x4*)(norm_final + 8 * ln + 512 * j), g1 = *(const f32x4*)(norm_final + 8 * ln + 512 * j + 4);
                *(f32x4*)(args.out + off + 512 * j) = v[2 * j] * g0 * rstd; *(f32x4*)(args.out + off + 512 * j + 4) = v[2 * j + 1] * g1 * rstd; }
        }
    }
#undef IN
#undef SEAM
}

extern "C" void kernel_launch(void* const* d_in, const int* in_sizes, int n_in, void* d_out, int out_size, void* d_ws, size_t ws_size, hipStream_t stream) {
    static int grid = 0;
    if (grid == 0) {
        if (n_in != 25 || out_size != NTOK * DM || ws_size < WS_END) { fprintf(stderr, "kernel_launch: unexpected shapes (n_in %d out %d ws %zu)\n", n_in, out_size, ws_size); grid = -1; return; }
        int dev = 0, cus = 0, per_cu = 0;
        if (hipGetDevice(&dev) != hipSuccess || hipDeviceGetAttribute(&cus, hipDeviceAttributeMultiprocessorCount, dev) != hipSuccess) { grid = -1; return; }
        if (hipFuncSetAttribute((const void*)hymba_fwd, hipFuncAttributeMaxDynamicSharedMemorySize, LDS_BYTES) != hipSuccess) { fprintf(stderr, "kernel_launch: hipFuncSetAttribute failed\n"); grid = -1; return; }
        if (hipOccupancyMaxActiveBlocksPerMultiprocessor(&per_cu, (const void*)hymba_fwd, NWAVES * 64, LDS_BYTES) != hipSuccess || per_cu < 1) fprintf(stderr, "kernel_launch: occupancy query reports %d\n", per_cu);
        (void)hipGetLastError();
        grid = cus;
        if (grid != 256) { fprintf(stderr, "kernel_launch: expected 256 CUs, got %d\n", cus); if (grid > 256) grid = 256; }
    }
    if (grid < 0) return;
    if (hipMemsetAsync((char*)d_ws + WS_CTL, 0, CTL_ZERO_BYTES, stream) != hipSuccess) return;
    Args a{};
    for (int i = 0; i < 25; ++i) a.in[i] = (const float*)d_in[i];
    a.out = (float*)d_out; a.ws = (unsigned char*)d_ws;
    a.ph_lo = 0; a.ph_hi = NPHASE;
    hipLaunchKernelGGL(hymba_fwd, dim3(grid), dim3(NWAVES * 64), LDS_BYTES, stream, a);
}
```

```cpp
#include <hip/hip_runtime.h>
#include <cstdio>
#include <cstdint>

#define LAS __attribute__((address_space(3)))
#define GAS __attribute__((address_space(1)))
typedef unsigned short bf16_t;
typedef short bf16x8 __attribute__((ext_vector_type(8)));
typedef short s16x4 __attribute__((ext_vector_type(4)));
typedef float f32x4 __attribute__((ext_vector_type(4)));
typedef float f32x2 __attribute__((ext_vector_type(2)));
typedef float f32x16 __attribute__((ext_vector_type(16)));
typedef unsigned u32x4 __attribute__((ext_vector_type(4)));
typedef unsigned u32x2 __attribute__((ext_vector_type(2)));
typedef int i32x4 __attribute__((ext_vector_type(4)));
typedef int i32x8 __attribute__((ext_vector_type(8)));

constexpr int NTOK = 65536, DM = 1024, SEQ = 2048, NBATCH = 32, PROJW = 3072, MEMLEN = 256, NMEMROW = NBATCH * MEMLEN;
constexpr int NEXP = 32, EFF = 512;
constexpr float RMS_EPS = 1e-6f, LOG2E = 1.4426950408889634f;
constexpr float C2_64 = 0.125f * LOG2E;
constexpr float C2_256 = 0.0625f * LOG2E;
constexpr int HROWS = 131072 + NEXP * 256;

constexpr size_t MiB = 1u << 20;
constexpr size_t WS_CTL = 0, CTL_ZERO_BYTES = 1 * MiB;
constexpr size_t WS_WIN = 2 * MiB, WS_WOUT = 8 * MiB, WS_WQ = 10 * MiB, WS_WKV = 12 * MiB, WS_WO = 16 * MiB, WS_WR = 18 * MiB;
constexpr size_t WS_WGU = 20 * MiB, WS_WD = 84 * MiB, WS_MEMN = 116 * MiB, WS_KVMEM = 132 * MiB;
constexpr size_t WS_KMS = 164 * MiB, WS_SSQA = 166 * MiB, WS_SSQ1 = 168 * MiB, WS_SSQ2 = 172 * MiB;
constexpr size_t WS_INVRX = 176 * MiB;
constexpr size_t WS_ROWTOK = 180 * MiB, WS_ROWW = 188 * MiB, WS_ROWRSTD = 196 * MiB;
constexpr size_t WS_R0 = 204 * MiB;
constexpr size_t WS_H1 = 332 * MiB;
constexpr size_t WS_H2 = 460 * MiB;
constexpr size_t WS_BIG = 588 * MiB;
constexpr size_t WS_QMEM = WS_BIG, WS_OMEM = WS_BIG + 128 * MiB, WS_HID = WS_BIG;
constexpr size_t WS_END = 972 * MiB;
constexpr int CW_BAR = 4096;
constexpr int CW_ECNT = 16384;

constexpr int RING_BYTES = 131072;
constexpr int MISC_OFF = RING_BYTES;
constexpr int LDS_BYTES = 163840;

__device__ __forceinline__ unsigned cvt_pk_bf16(float lo, float hi) { unsigned r; asm volatile("v_cvt_pk_bf16_f32 %0, %1, %2" : "=v"(r) : "v"(lo), "v"(hi)); return r; }
__device__ __forceinline__ unsigned pk4_fp8(float a, float b, float c, float d) {
    a = __builtin_amdgcn_fmed3f(a, -448.f, 448.f); b = __builtin_amdgcn_fmed3f(b, -448.f, 448.f); c = __builtin_amdgcn_fmed3f(c, -448.f, 448.f); d = __builtin_amdgcn_fmed3f(d, -448.f, 448.f);
    int w = 0; w = __builtin_amdgcn_cvt_pk_fp8_f32(a, b, w, false); w = __builtin_amdgcn_cvt_pk_fp8_f32(c, d, w, true); return (unsigned)w; }
constexpr float SW8 = 32.f, SD8 = 16.f, SH8 = 16.f;
__device__ __forceinline__ float bf_lo(unsigned u) { return __uint_as_float(u << 16); }
__device__ __forceinline__ float bf_hi(unsigned u) { return __uint_as_float(u & 0xffff0000u); }
__device__ __forceinline__ float wave_sum(float v) {
#pragma unroll
    for (int o = 1; o < 64; o <<= 1) v += __shfl_xor(v, o);
    return v;
}
__device__ __forceinline__ float xhalf_max(float m) { auto rr = __builtin_amdgcn_permlane32_swap(__float_as_uint(m), __float_as_uint(m), false, false); return fmaxf(__uint_as_float(rr[0]), __uint_as_float(rr[1])); }
__device__ __forceinline__ float xhalf_sum(float m) { auto rr = __builtin_amdgcn_permlane32_swap(__float_as_uint(m), __float_as_uint(m), false, false); return __uint_as_float(rr[0]) + __uint_as_float(rr[1]); }
__device__ __forceinline__ int crow(int r, int hi) { return (r & 3) + 8 * (r >> 2) + 4 * hi; }
#define LDS_WAIT() asm volatile("s_waitcnt lgkmcnt(0)" ::: "memory")
#define VM_WAIT() asm volatile("s_waitcnt vmcnt(0)" ::: "memory")

namespace pg8 {
constexpr int BM = 256, BK = 64, HALF = 128, HTB = HALF * BK * 2, STAGE_BYTES = 8 * HTB, NXCD = 8, WGM = 8;
__host__ __device__ __forceinline__ int lds_byte(int r, int c) { const int st = (r >> 4) * 2 + (c >> 5), rr = r & 15, cc = c & 31, ob = rr * 64 + cc * 2; return st * 1024 + (ob ^ (((ob >> 9) & 1) << 5)); }
__host__ __device__ __forceinline__ void stage_rc(int b, int& R, int& C) { const int st = b / 1024, sb = b % 1024, swz = sb ^ (((sb >> 9) & 1) << 5); R = (st >> 1) * 16 + swz / 64; C = (st & 1) * 32 + (swz % 64) / 2; }
__host__ __device__ __forceinline__ int perm32(int rho) { const int n = rho >> 4, i = rho & 15; return 8 * (i >> 2) + 4 * n + (i & 3); }

struct Unit { int pm, pn; const char* a; const char* b; int e, cnt, row0, ui; };

struct DenseOrder {
    const char* A; const char* Bt; int K; int nM, nN, nwg, G, c; int esz; bool gat;
    __device__ void init(const void* A_, const void* Bt_, int M, int N, int K_, int G_, int c_, int esz_ = 2, bool gat_ = false) { A = (const char*)A_; Bt = (const char*)Bt_; K = K_; nM = M / BM; nN = N / BM; nwg = nM * nN; G = G_; c = c_; esz = esz_; gat = gat_; }
    __device__ bool next(int i, Unit& u) const {
        const long L = (long)i * G + c; if (L >= nwg) return false;
        int wgid = (int)L; { const int q = nwg / NXCD, r = nwg % NXCD, xcd = wgid % NXCD, off = wgid / NXCD; wgid = (xcd < r ? xcd * (q + 1) : r * (q + 1) + (xcd - r) * q) + off; }
        const int nig = WGM * nN, gid = wgid / nig, fm = gid * WGM, gsz = (nM - fm) < WGM ? (nM - fm) : WGM;
        u.pm = fm + ((wgid % nig) % gsz); u.pn = (wgid % nig) / gsz;
        u.a = gat ? A : A + (size_t)u.pm * BM * K * esz; u.b = Bt + (size_t)u.pn * BM * K * esz; u.e = 0; u.cnt = 256; u.row0 = u.pm * BM; u.ui = i; return true;
    }
    __device__ __forceinline__ int rowidx(const Unit& u, int r) const { return u.row0 + r; }
};

template <class Epi, class Sched, bool ALIGN_EPI, bool GATHER, bool MID, bool FP8 = false>
__device__ __forceinline__ void gemm_phase(LAS unsigned char* lds, const int K_, const Sched& S, const Epi& E) {
    int K = K_; if constexpr (FP8) asm volatile("" : "+s"(K));
    const int tid = threadIdx.x, wid = __builtin_amdgcn_readfirstlane(tid >> 6), lane = tid & 63, wr = wid >> 2, wc = wid & 3, fr = lane & 15, fq = lane >> 4;
    const int nt = FP8 ? K / 128 : K / BK;
    constexpr int ESZ = FP8 ? 1 : 2;
    unsigned voffB[2];
#pragma unroll
    for (int i = 0; i < 2; ++i) { int R, C; stage_rc(tid * 16 + i * 8192, R, C); const int Rb = Epi::PERM ? ((R & ~31) + perm32(R & 31)) : R; voffB[i] = FP8 ? (unsigned)(Rb * K + C * 2) : (unsigned)(Rb * K + C) * 2u; }
    const size_t kstep = (size_t)(BK * 2);
    const size_t hstep = (size_t)HALF * K * ESZ;
    const unsigned ldsw = (unsigned)wid * 1024u;
    const int aoff0 = lds_byte(wr * 64 + fr, fq * 8), aoff1 = aoff0 + 1024;
    const int boff0 = lds_byte(wc * 32 + fr, fq * 8), boff1 = boff0 + 1024;
#define PG8_SA(b, h) (((b) * 2 + (h)) * HTB)
#define PG8_SB(b, h) ((4 + (b) * 2 + (h)) * HTB)
#define PG8_STAGE(bufoff, gbase, voff) do { _Pragma("unroll") for (int _i = 0; _i < 2; ++_i) \
        __builtin_amdgcn_global_load_lds((const unsigned*)((const char*)(gbase) + (voff)[_i]), (LAS unsigned*)(lds + (bufoff) + ldsw + _i * 8192), 16, 0, 0); } while (0)
#define PG8_LD8(p) ({ const i32x4 lo_ = *(const LAS i32x4*)(p), hi_ = *(const LAS i32x4*)((p) + 0); (void)hi_; lo_; })
#define PG8_LDA(dst, b, h) do { if constexpr (FP8) { _Pragma("unroll") for (int m = 0; m < 4; ++m) { const i32x4 lo_ = *(const LAS i32x4*)(lds + PG8_SA(b, h) + aoff0 + m * 2048), hi_ = *(const LAS i32x4*)(lds + PG8_SA(b, h) + aoff1 + m * 2048); \
            dst##8[m] = (i32x8){lo_[0], lo_[1], lo_[2], lo_[3], hi_[0], hi_[1], hi_[2], hi_[3]}; } } \
        else { _Pragma("unroll") for (int m = 0; m < 4; ++m) _Pragma("unroll") for (int k = 0; k < 2; ++k) dst[m][k] = *(const LAS bf16x8*)(lds + PG8_SA(b, h) + (k ? aoff1 : aoff0) + m * 2048); } } while (0)
#define PG8_LDB(dst, b, h) do { if constexpr (FP8) { _Pragma("unroll") for (int n = 0; n < 2; ++n) { const i32x4 lo_ = *(const LAS i32x4*)(lds + PG8_SB(b, h) + boff0 + n * 2048), hi_ = *(const LAS i32x4*)(lds + PG8_SB(b, h) + boff1 + n * 2048); \
            dst##8[n] = (i32x8){lo_[0], lo_[1], lo_[2], lo_[3], hi_[0], hi_[1], hi_[2], hi_[3]}; } } \
        else { _Pragma("unroll") for (int n = 0; n < 2; ++n) _Pragma("unroll") for (int k = 0; k < 2; ++k) dst[n][k] = *(const LAS bf16x8*)(lds + PG8_SB(b, h) + (k ? boff1 : boff0) + n * 2048); } } while (0)
#define PG8_MMA(ai, bj, At, Bt) do { __builtin_amdgcn_s_setprio(1); _Pragma("unroll") for (int m = 0; m < 4; ++m) _Pragma("unroll") for (int n = 0; n < 2; ++n) { \
        if constexpr (FP8) acc[ai][bj][m][n] = __builtin_amdgcn_mfma_scale_f32_16x16x128_f8f6f4(Bt##8[n], At##8[m], acc[ai][bj][m][n], 0, 0, 0, 0x7f7f7f7f, 0, 0x7f7f7f7f); \
        else { _Pragma("unroll") for (int k = 0; k < 2; ++k) acc[ai][bj][m][n] = __builtin_amdgcn_mfma_f32_16x16x32_bf16(Bt[n][k], At[m][k], acc[ai][bj][m][n], 0, 0, 0); } } \
        __builtin_amdgcn_s_setprio(0); } while (0)
#define PG8_WAIT_V(n) asm volatile("s_waitcnt vmcnt(" #n ")" ::: "memory")
#define PG8_WAIT_L(n) asm volatile("s_waitcnt lgkmcnt(" #n ")" ::: "memory")
#define PG8_BAR __builtin_amdgcn_s_barrier()
#define PG8_SCHED __builtin_amdgcn_sched_barrier(0)
#define PG8_MKVO(u, vo) do { _Pragma("unroll") for (int _h = 0; _h < 2; ++_h) _Pragma("unroll") for (int _i = 0; _i < 2; ++_i) { int _R, _C; stage_rc(tid * 16 + _i * 8192, _R, _C); const int _r = _h * HALF + _R; \
        const int _src = GATHER ? S.rowidx(u, _r) : _r; vo[_h][_i] = FP8 ? (unsigned)(_src * K + _C * 2) : (unsigned)(_src * K + _C) * 2u; } } while (0)
    Unit cur, nxt; int ui = 0;
    if (!S.next(0, cur)) return;
    f32x4 acc[2][2][4][2];
#pragma unroll
    for (int a = 0; a < 2; ++a)
#pragma unroll
        for (int b = 0; b < 2; ++b)
#pragma unroll
            for (int m = 0; m < 4; ++m)
#pragma unroll
                for (int n = 0; n < 2; ++n) acc[a][b][m][n] = (f32x4){0.f, 0.f, 0.f, 0.f};
    bf16x8 At[4][2], B0[2][2], B1[2][2];
    i32x8 At8[4], B08[2], B18[2];
    unsigned vo[2][2];
    LAS u32x4* nvo_lds = (LAS u32x4*)(lds + STAGE_BYTES + 8192) + tid;
    PG8_MKVO(cur, vo);
    const char* cA = cur.a; const char* cB = cur.b;
    PG8_STAGE(PG8_SB(0, 0), cB, voffB); PG8_STAGE(PG8_SB(0, 1), cB + hstep, voffB); PG8_STAGE(PG8_SA(0, 0), cA, vo[0]); PG8_STAGE(PG8_SA(0, 1), cA, vo[1]);
    if (wr == 1) PG8_BAR;
    PG8_WAIT_V(2); PG8_BAR;
    PG8_STAGE(PG8_SB(1, 0), cB + kstep, voffB); PG8_STAGE(PG8_SA(1, 0), cA + kstep, vo[0]); PG8_STAGE(PG8_SB(1, 1), cB + hstep + kstep, voffB);
    PG8_WAIT_V(6); PG8_BAR;
    for (;;) {
        if constexpr (Epi::HOOK) E.begin(cur, lds + STAGE_BYTES);
        const bool has_next = S.next(ui + 1, nxt);
        const char* nA = has_next ? nxt.a : cA; const char* nB = has_next ? nxt.b : cB;
        if constexpr (GATHER) { unsigned nvo[2][2]; if (has_next) { PG8_MKVO(nxt, nvo); } else {
#pragma unroll
            for (int h = 0; h < 2; ++h)
#pragma unroll
                for (int i = 0; i < 2; ++i) nvo[h][i] = vo[h][i]; }
            *nvo_lds = (u32x4){nvo[0][0], nvo[0][1], nvo[1][0], nvo[1][1]}; }
#pragma unroll 1
        for (int t = 0; t < nt; t += 2) {
            const bool last = (t == nt - 2);
            if constexpr (MID) { if (t == (nt >> 1)) E.mid(acc, cur, wr, fr); }
            const char* a1 = cA + (size_t)(t + 1) * kstep;
            const char* a2 = last ? nA : cA + (size_t)(t + 2) * kstep; const char* b2 = last ? nB : cB + (size_t)(t + 2) * kstep;
            const char* a3 = a2 + kstep; const char* b3 = b2 + kstep;
            PG8_LDB(B0, 0, 0); PG8_LDB(B1, 0, 1); PG8_SCHED; PG8_LDA(At, 0, 0); PG8_STAGE(PG8_SA(1, 1), a1, vo[1]);
            if constexpr (GATHER) { if (last) { const u32x4 nv = *nvo_lds; vo[0][0] = nv.x; vo[0][1] = nv.y; vo[1][0] = nv.z; vo[1][1] = nv.w; } }
            PG8_WAIT_V(8); PG8_WAIT_L(0); PG8_BAR; PG8_MMA(0, 0, At, B0); PG8_MMA(0, 1, At, B1); PG8_BAR; PG8_SCHED;
            PG8_LDA(At, 0, 1); PG8_STAGE(PG8_SB(0, 0), b2, voffB); PG8_STAGE(PG8_SB(0, 1), b2 + hstep, voffB); PG8_STAGE(PG8_SA(0, 0), a2, vo[0]);
            PG8_WAIT_V(8); PG8_WAIT_L(0); PG8_BAR; PG8_MMA(1, 0, At, B0); PG8_MMA(1, 1, At, B1); PG8_BAR; PG8_SCHED;
            PG8_LDB(B0, 1, 0); PG8_LDB(B1, 1, 1); PG8_SCHED; PG8_LDA(At, 1, 0); PG8_STAGE(PG8_SA(0, 1), a2, vo[1]);
            PG8_WAIT_V(8); PG8_WAIT_L(0); PG8_BAR; PG8_MMA(0, 0, At, B0); PG8_MMA(0, 1, At, B1); PG8_BAR; PG8_SCHED;
            PG8_LDA(At, 1, 1); PG8_STAGE(PG8_SB(1, 0), b3, voffB); PG8_STAGE(PG8_SB(1, 1), b3 + hstep, voffB); PG8_STAGE(PG8_SA(1, 0), a3, vo[0]);
            PG8_WAIT_V(8); PG8_WAIT_L(0); PG8_BAR; PG8_MMA(1, 0, At, B0); PG8_MMA(1, 1, At, B1); PG8_BAR; PG8_SCHED;
        }
        if constexpr (ALIGN_EPI) { if (wr == 0) PG8_BAR; }
        if constexpr (!Epi::AFTER_DRAIN) { E(acc, cur, wr, wc, fr, fq); }
        if (!has_next) break;
#pragma unroll
        for (int a = 0; a < 2; ++a)
#pragma unroll
            for (int b = 0; b < 2; ++b)
#pragma unroll
                for (int m = 0; m < 4; ++m)
#pragma unroll
                    for (int n = 0; n < 2; ++n) acc[a][b][m][n] = (f32x4){0.f, 0.f, 0.f, 0.f};
        cur = nxt; cA = nA; cB = nB; ++ui;
        if constexpr (ALIGN_EPI) { if (wr == 1) PG8_BAR; }
    }
    PG8_WAIT_V(0);
    if constexpr (!ALIGN_EPI) { if (wr == 0) PG8_BAR; }
    PG8_BAR;
    if constexpr (Epi::AFTER_DRAIN) { E.fused(acc, cur, wr, wc, fr, fq, lds, wid, lane); }
#undef PG8_SA
#undef PG8_SB
#undef PG8_STAGE
#undef PG8_LDA
#undef PG8_LDB
#undef PG8_MMA
#undef PG8_WAIT_V
#undef PG8_WAIT_L
#undef PG8_BAR
#undef PG8_SCHED
#undef PG8_MKVO
#undef PG8_LD8
}

#define ACC_T const f32x4 (&acc)[2][2][4][2]
__device__ __forceinline__ u32x4 pack8(f32x4 v0, f32x4 v1) { u32x4 w; w.x = cvt_pk_bf16(v0[0], v0[1]); w.y = cvt_pk_bf16(v0[2], v0[3]); w.z = cvt_pk_bf16(v1[0], v1[1]); w.w = cvt_pk_bf16(v1[2], v1[3]); return w; }

constexpr size_t PREG = (size_t)NTOK * 512;
__device__ __forceinline__ size_t proj_off(int c, int& rstride) {
    if (c < 1536) { rstride = 64; return (size_t)(c >> 9) * PREG + (size_t)((c & 511) >> 6) * (SEQ * 64) + (c & 63); }
    if (c < 2560) { const int cc = c - 1536; rstride = 64; return (size_t)(3 + (cc >> 9)) * PREG + (size_t)((cc & 511) >> 6) * (SEQ * 64) + (cc & 63); }
    const int cc = c - 2560; rstride = 128; return 5 * PREG + (size_t)(cc >> 7) * (SEQ * 128) + (cc & 127);
}
struct EpiProj {
    static constexpr bool PERM = true, AFTER_DRAIN = false, HOOK = false;
    bf16_t* O; float* kms;
    __device__ __forceinline__ void operator()(ACC_T, const Unit& u, int wr, int wc, int fr, int fq) const {
        const int pn = u.pn; const float sc = (pn < 2 || (pn >= 6 && pn < 8)) ? C2_64 : 1.f;
        const int bq = u.pm >> 3, s0 = (u.pm & 7) * 256 + wr * 64 + fr;
        bf16_t* ob[2]; int rs[2];
#pragma unroll
        for (int bj = 0; bj < 2; ++bj) { const int c = pn * BM + bj * HALF + wc * 32 + 8 * fq; int st; const size_t off = proj_off(c, st); ob[bj] = O + off + ((size_t)bq << 20); rs[bj] = st; }
#pragma unroll
        for (int ai = 0; ai < 2; ++ai)
#pragma unroll
            for (int m = 0; m < 4; ++m) { const int srow = s0 + ai * HALF + m * 16;
#pragma unroll
                for (int bj = 0; bj < 2; ++bj) *(u32x4*)(ob[bj] + (size_t)srow * rs[bj]) = pack8(acc[ai][bj][m][0] * sc, acc[ai][bj][m][1] * sc); }
        if (pn == 2 || pn == 3) {
            f32x4 cs[2][2];
#pragma unroll
            for (int bj = 0; bj < 2; ++bj)
#pragma unroll
                for (int n = 0; n < 2; ++n) { f32x4 s = (f32x4){0.f, 0.f, 0.f, 0.f};
#pragma unroll
                    for (int ai = 0; ai < 2; ++ai)
#pragma unroll
                        for (int m = 0; m < 4; ++m) s += acc[ai][bj][m][n];
#pragma unroll
                    for (int o = 1; o < 16; o <<= 1) { s[0] += __shfl_xor(s[0], o); s[1] += __shfl_xor(s[1], o); s[2] += __shfl_xor(s[2], o); s[3] += __shfl_xor(s[3], o); }
                    cs[bj][n] = s; }
            if (fr == 0) { float* kp = kms + ((size_t)wr * 256 + u.pm) * 512 + (pn - 2) * 256 + wc * 32 + 8 * fq;
#pragma unroll
                for (int bj = 0; bj < 2; ++bj) { *(f32x4*)(kp + bj * HALF) = cs[bj][0]; *(f32x4*)(kp + bj * HALF + 4) = cs[bj][1]; } }
        }
    }
};
struct EpiPlain {
    static constexpr bool PERM = true, AFTER_DRAIN = false, HOOK = false;
    bf16_t* O; int ldc; float sc;
    __device__ __forceinline__ void operator()(ACC_T, const Unit& u, int wr, int wc, int fr, int fq) const {
        const int row0 = u.pm * BM + wr * 64 + fr, col0 = u.pn * BM + wc * 32 + 8 * fq;
#pragma unroll
        for (int ai = 0; ai < 2; ++ai)
#pragma unroll
            for (int m = 0; m < 4; ++m) { bf16_t* rowp = O + (size_t)(row0 + ai * HALF + m * 16) * ldc + col0;
#pragma unroll
                for (int bj = 0; bj < 2; ++bj) *(u32x4*)(rowp + bj * HALF) = pack8(acc[ai][bj][m][0] * sc, acc[ai][bj][m][1] * sc); }
    }
};
__device__ __forceinline__ void ssq_partial(float q, float* ssq, int row, int slot, int fq) {
    q += __shfl_xor(q, 16); q += __shfl_xor(q, 32);
    if (fq == 0) ssq[(size_t)row * 16 + slot] = q;
}
struct EpiOut {
    static constexpr bool PERM = true, AFTER_DRAIN = false, HOOK = true;
    const bf16_t* hn; const float* invrx; const float* gmix; const float* ssqA; bf16_t* h1; float* ssq1; unsigned char* h1f8; LAS unsigned char* meta;
    __device__ __forceinline__ void begin(const Unit& u, LAS unsigned char*) const {
        if (threadIdx.x < 256) { const int row = u.pm * BM + threadIdx.x;
            const f32x4 a = *(const f32x4*)(ssqA + (size_t)row * 8), b = *(const f32x4*)(ssqA + (size_t)row * 8 + 4);
            const float s = ((a[0] + a[1]) + (a[2] + a[3])) + ((b[0] + b[1]) + (b[2] + b[3]));
            ((LAS f32x2*)(meta + (u.ui & 1) * 2048))[threadIdx.x] = (f32x2){1.0f / sqrtf(s * (1.0f / 512.0f) + RMS_EPS), invrx[row]}; }
    }
    __device__ __forceinline__ void mid(f32x4 (&acc)[2][2][4][2], const Unit& u, int wr, int fr) const {
        const LAS f32x2* mt = (const LAS f32x2*)(meta + (u.ui & 1) * 2048);
#pragma unroll
        for (int ai = 0; ai < 2; ++ai)
#pragma unroll
            for (int m = 0; m < 4; ++m) { const float r = mt[ai * HALF + wr * 64 + m * 16 + fr][0];
#pragma unroll
                for (int bj = 0; bj < 2; ++bj)
#pragma unroll
                    for (int n = 0; n < 2; ++n) acc[ai][bj][m][n] *= r; }
    }
    __device__ __forceinline__ void operator()(ACC_T, const Unit& u, int wr, int wc, int fr, int fq) const {
        const LAS f32x2* mt = (const LAS f32x2*)(meta + (u.ui & 1) * 2048);
        const int row0 = u.pm * BM + wr * 64 + fr, col0 = u.pn * BM + wc * 32 + 8 * fq;
        f32x4 ig[2][2];
#pragma unroll
        for (int bj = 0; bj < 2; ++bj)
#pragma unroll
            for (int n = 0; n < 2; ++n) { const f32x4 g = *(const f32x4*)(gmix + col0 + bj * HALF + 4 * n);
                ig[bj][n] = (f32x4){__builtin_amdgcn_rcpf(g[0]), __builtin_amdgcn_rcpf(g[1]), __builtin_amdgcn_rcpf(g[2]), __builtin_amdgcn_rcpf(g[3])}; }
#pragma unroll
        for (int ai = 0; ai < 2; ++ai) {
            u32x4 hv[4][2];
#pragma unroll
            for (int m = 0; m < 4; ++m) { const size_t off = (size_t)(row0 + ai * HALF + m * 16) * DM + col0;
#pragma unroll
                for (int bj = 0; bj < 2; ++bj) hv[m][bj] = *(const u32x4*)(hn + off + bj * HALF); }
#pragma unroll
            for (int m = 0; m < 4; ++m) { const int row = row0 + ai * HALF + m * 16; const size_t off = (size_t)row * DM + col0; float q = 0.f;
                const float ir = mt[ai * HALF + wr * 64 + m * 16 + fr][1];
#pragma unroll
                for (int bj = 0; bj < 2; ++bj) { const u32x4 hb = hv[m][bj];
                    const f32x4 v0 = acc[ai][bj][m][0] + (f32x4){bf_lo(hb.x), bf_hi(hb.x), bf_lo(hb.y), bf_hi(hb.y)} * ig[bj][0] * ir, v1 = acc[ai][bj][m][1] + (f32x4){bf_lo(hb.z), bf_hi(hb.z), bf_lo(hb.w), bf_hi(hb.w)} * ig[bj][1] * ir;
                    q += (v0[0] * v0[0] + v0[1] * v0[1]) + (v0[2] * v0[2] + v0[3] * v0[3]) + (v1[0] * v1[0] + v1[1] * v1[1]) + (v1[2] * v1[2] + v1[3] * v1[3]);
                    *(u32x4*)(h1 + off + bj * HALF) = pack8(v0, v1);
                    *(u32x2*)(h1f8 + off + bj * HALF) = (u32x2){pk4_fp8(v0[0], v0[1], v0[2], v0[3]), pk4_fp8(v1[0], v1[1], v1[2], v1[3])}; }
                ssq_partial(q, ssq1, row, u.pn * 4 + wc, fq); }
            asm volatile("" ::: "memory"); }
    }
};
__device__ __forceinline__ float rstd_from16(const float* ssq, int row) {
    const f32x4 a = *(const f32x4*)(ssq + (size_t)row * 16), b = *(const f32x4*)(ssq + (size_t)row * 16 + 4), c = *(const f32x4*)(ssq + (size_t)row * 16 + 8), d = *(const f32x4*)(ssq + (size_t)row * 16 + 12);
    const float s = (((a[0] + a[1]) + (a[2] + a[3])) + ((b[0] + b[1]) + (b[2] + b[3]))) + (((c[0] + c[1]) + (c[2] + c[3])) + ((d[0] + d[1]) + (d[2] + d[3])));
    return 1.0f / sqrtf(s * (1.0f / 1024.0f) + RMS_EPS);
}
struct EpiQ {
    static constexpr bool PERM = true, AFTER_DRAIN = false, HOOK = true;
    const float* ssq1; bf16_t* O; LAS unsigned char* misc;
    __device__ __forceinline__ void begin(const Unit& u, LAS unsigned char*) const {
        if (threadIdx.x < 256) ((LAS float*)(misc + ((u.ui & 1) ? 5120 : 3072)))[threadIdx.x] = rstd_from16(ssq1, u.pm * BM + threadIdx.x) * (C2_256 / SW8);
    }
    __device__ __forceinline__ void operator()(ACC_T, const Unit& u, int wr, int wc, int fr, int fq) const {
        const int row0 = u.pm * BM + wr * 64 + fr, col0 = u.pn * BM + wc * 32 + 8 * fq;
        const LAS float* tab = (const LAS float*)(misc + ((u.ui & 1) ? 5120 : 3072));
#pragma unroll
        for (int ai = 0; ai < 2; ++ai)
#pragma unroll
            for (int m = 0; m < 4; ++m) { const float r = tab[ai * HALF + wr * 64 + m * 16 + fr]; bf16_t* rowp = O + (size_t)(row0 + ai * HALF + m * 16) * DM + col0;
#pragma unroll
                for (int bj = 0; bj < 2; ++bj) *(u32x4*)(rowp + bj * HALF) = pack8(acc[ai][bj][m][0] * r, acc[ai][bj][m][1] * r); }
    }
};
struct EpiRes {
    static constexpr bool PERM = true, AFTER_DRAIN = false, HOOK = false;
    const bf16_t* h1; bf16_t* h2; float* ssq2; unsigned char* h2f8; float asc;
    __device__ __forceinline__ void operator()(ACC_T, const Unit& u, int wr, int wc, int fr, int fq) const {
        const int row0 = u.pm * BM + wr * 64 + fr, col0 = u.pn * BM + wc * 32 + 8 * fq;
        u32x4 hv[2][4][2];
#pragma unroll
        for (int ai = 0; ai < 2; ++ai)
#pragma unroll
            for (int m = 0; m < 4; ++m) { const size_t off = (size_t)(row0 + ai * HALF + m * 16) * DM + col0;
#pragma unroll
                for (int bj = 0; bj < 2; ++bj) hv[ai][m][bj] = *(const u32x4*)(h1 + off + bj * HALF); }
#pragma unroll
        for (int ai = 0; ai < 2; ++ai)
#pragma unroll
            for (int m = 0; m < 4; ++m) { const int row = row0 + ai * HALF + m * 16; const size_t off = (size_t)row * DM + col0; float q = 0.f;
#pragma unroll
                for (int bj = 0; bj < 2; ++bj) { const u32x4 hb = hv[ai][m][bj];
                    const f32x4 v0 = acc[ai][bj][m][0] * asc + (f32x4){bf_lo(hb.x), bf_hi(hb.x), bf_lo(hb.y), bf_hi(hb.y)}, v1 = acc[ai][bj][m][1] * asc + (f32x4){bf_lo(hb.z), bf_hi(hb.z), bf_lo(hb.w), bf_hi(hb.w)};
                    q += (v0[0] * v0[0] + v0[1] * v0[1]) + (v0[2] * v0[2] + v0[3] * v0[3]) + (v1[0] * v1[0] + v1[1] * v1[1]) + (v1[2] * v1[2] + v1[3] * v1[3]);
                    *(u32x4*)(h2 + off + bj * HALF) = pack8(v0, v1);
                    *(u32x2*)(h2f8 + off + bj * HALF) = (u32x2){pk4_fp8(v0[0], v0[1], v0[2], v0[3]), pk4_fp8(v1[0], v1[1], v1[2], v1[3])}; }
                ssq_partial(q, ssq2, row, u.pn * 4 + wc, fq); }
    }
};
struct EpiRouter {
    static constexpr bool PERM = false, AFTER_DRAIN = true, HOOK = false;
    const float* ssq2; const float* b_rg; const float* b_re; unsigned* ecnt; int* rowtok; float* roww; float* rowrstd;
    __device__ __forceinline__ void operator()(ACC_T, const Unit&, int, int, int, int) const {}
    __device__ __forceinline__ void fused(f32x4 (&acc)[2][2][4][2], const Unit& u, int wr, int wc, int fr, int fq, LAS unsigned char* lds, int wid, int lane) const {
        LAS float* L = (LAS float*)lds;
        LAS int* lcnt = (LAS int*)(lds + 49152); LAS int* lbase = lcnt + 32;
        const int tid = threadIdx.x;
        if (tid < 32) lcnt[tid] = 0;
        if (wc == 0) {
#pragma unroll
            for (int ai = 0; ai < 2; ++ai)
#pragma unroll
                for (int m = 0; m < 4; ++m) { const int rl = ai * HALF + wr * 64 + m * 16 + fr;
                    *(LAS f32x4*)(L + rl * 40 + 4 * fq) = acc[ai][0][m][0]; *(LAS f32x4*)(L + rl * 40 + 16 + 4 * fq) = acc[ai][0][m][1]; }
        } else if (wc == 1 && fq == 0) {
#pragma unroll
            for (int ai = 0; ai < 2; ++ai)
#pragma unroll
                for (int m = 0; m < 4; ++m) { const int rl = ai * HALF + wr * 64 + m * 16 + fr; *(LAS f32x4*)(L + rl * 40 + 32) = acc[ai][0][m][0]; }
        }
        __syncthreads();
        int e0 = 0, e1 = 0, p0 = 0, p1 = 0; float cw0 = 0.f, cw1 = 0.f, rs = 0.f; const int row = u.pm * BM + tid;
        if (tid < 256) {
            rs = rstd_from16(ssq2, row);
            float gl[4];
#pragma unroll
            for (int g = 0; g < 4; ++g) gl[g] = L[tid * 40 + g] * rs + b_rg[g];
            int grp = 0; float gm = gl[0];
#pragma unroll
            for (int g = 1; g < 4; ++g) if (gl[g] > gm) { gm = gl[g]; grp = g; }
            float gs = 0.f;
#pragma unroll
            for (int g = 0; g < 4; ++g) gs += __expf(gl[g] - gm);
            const float gw = 1.0f / gs;
            float ev[8];
#pragma unroll
            for (int i = 0; i < 8; ++i) ev[i] = L[tid * 40 + 4 + grp * 8 + i] * rs + b_re[grp * 8 + i];
            int i0 = 0; float v0 = ev[0];
#pragma unroll
            for (int i = 1; i < 8; ++i) if (ev[i] > v0) { v0 = ev[i]; i0 = i; }
            int i1 = -1; float v1 = -3.0e38f;
#pragma unroll
            for (int i = 0; i < 8; ++i) if (i != i0 && ev[i] > v1) { v1 = ev[i]; i1 = i; }
            const float w0 = 1.0f / (1.0f + __expf(v1 - v0)), w1 = 1.0f - w0;
            e0 = grp * 8 + i0; e1 = grp * 8 + i1; cw0 = gw * w0; cw1 = gw * w1;
            p0 = __hip_atomic_fetch_add(&lcnt[e0], 1, __ATOMIC_RELAXED, __HIP_MEMORY_SCOPE_WORKGROUP); p1 = __hip_atomic_fetch_add(&lcnt[e1], 1, __ATOMIC_RELAXED, __HIP_MEMORY_SCOPE_WORKGROUP);
        }
        __syncthreads();
        if (tid < 32) lbase[tid] = (int)__hip_atomic_fetch_add(ecnt + tid, (unsigned)lcnt[tid], __ATOMIC_RELAXED, __HIP_MEMORY_SCOPE_AGENT);
        __syncthreads();
        if (tid < 256) {
            const int q0 = lbase[e0] + p0, q1 = lbase[e1] + p1;
            rowtok[(size_t)e0 * NTOK + q0] = row * 2; roww[(size_t)e0 * NTOK + q0] = cw0; rowrstd[(size_t)e0 * NTOK + q0] = rs;
            rowtok[(size_t)e1 * NTOK + q1] = row * 2 + 1; roww[(size_t)e1 * NTOK + q1] = cw1; rowrstd[(size_t)e1 * NTOK + q1] = rs;
        }
    }
};
struct MoeOrder {
    const LAS int* tab; const char* A; const char* Bt; const int* rowtok; int K, G, c; bool up; int esz;
    __device__ __forceinline__ bool next(int i, Unit& u) const {
        if (i >= 16) return false;
        const i32x4 t0 = *(const LAS i32x4*)(tab + 128 + 8 * i); const int r0 = tab[128 + 8 * i + 4];
        const int e = __builtin_amdgcn_readfirstlane(t0[0]); if (e < 0) return false;
        const int rt = __builtin_amdgcn_readfirstlane(t0[1]), pn = __builtin_amdgcn_readfirstlane(t0[2]);
        u.ui = i; u.e = e; u.pm = rt; u.pn = pn; u.cnt = __builtin_amdgcn_readfirstlane(t0[3]); u.row0 = __builtin_amdgcn_readfirstlane(r0);
        u.b = Bt + ((size_t)e * 1024 + (size_t)pn * 256) * K * esz;
        u.a = A;
        return true;
    }
    __device__ __forceinline__ int rowidx(const Unit& u, int r) const { return up ? (rowtok[(size_t)u.e * NTOK + u.pm * 256 + min(r, u.cnt - 1)] >> 1) : u.row0 + r; }
};
struct EpiUp {
    static constexpr bool PERM = true, AFTER_DRAIN = false, HOOK = true;
    const float* roww; const float* rowrstd; unsigned char* H; LAS unsigned char* meta;
    __device__ __forceinline__ void begin(const Unit& u, LAS unsigned char*) const {
        if (threadIdx.x < 256) { const size_t li = (size_t)u.e * NTOK + u.pm * 256 + min((int)threadIdx.x, u.cnt - 1);
            ((LAS f32x2*)(meta + (u.ui & 1) * 2048))[threadIdx.x] = (f32x2){rowrstd[li] * (1.0f / SW8), roww[li] * SH8}; }
    }
    __device__ __forceinline__ void operator()(ACC_T, const Unit& u, int wr, int wc, int fr, int fq) const {
        const LAS f32x2* mt = (const LAS f32x2*)(meta + (u.ui & 1) * 2048);
#pragma unroll
        for (int ai = 0; ai < 2; ++ai)
#pragma unroll
            for (int m = 0; m < 4; ++m) { const int rl = ai * HALF + wr * 64 + m * 16 + fr;
                if (rl < u.cnt) { const f32x2 mv = mt[rl]; const float rs = mv[0], w = mv[1];
                    f32x4 o[2];
#pragma unroll
                    for (int n = 0; n < 2; ++n)
#pragma unroll
                        for (int j = 0; j < 4; ++j) { const float g = acc[ai][0][m][n][j] * rs, up = acc[ai][1][m][n][j] * rs;
                            o[n][j] = g * __builtin_amdgcn_rcpf(1.0f + __builtin_amdgcn_exp2f(-g * LOG2E)) * up * w; }
                    *(u32x2*)(H + (size_t)(u.row0 + rl) * EFF + u.pn * 128 + wc * 32 + 8 * fq) = (u32x2){pk4_fp8(o[0][0], o[0][1], o[0][2], o[0][3]), pk4_fp8(o[1][0], o[1][1], o[1][2], o[1][3])}; } }
    }
};
struct EpiDown {
    static constexpr bool PERM = true, AFTER_DRAIN = false, HOOK = true;
    const int* rowtok; unsigned char* y0; unsigned char* y1; LAS unsigned char* meta;
    __device__ __forceinline__ void begin(const Unit& u, LAS unsigned char*) const {
        if (threadIdx.x < 256) ((LAS int*)(meta + (u.ui & 1) * 1024))[threadIdx.x] = rowtok[(size_t)u.e * NTOK + u.pm * 256 + min((int)threadIdx.x, u.cnt - 1)];
    }
    __device__ __forceinline__ void operator()(ACC_T, const Unit& u, int wr, int wc, int fr, int fq) const {
        const LAS int* mt = (const LAS int*)(meta + (u.ui & 1) * 1024);
        const float sc = 1.0f / SD8;
#pragma unroll
        for (int ai = 0; ai < 2; ++ai)
#pragma unroll
            for (int m = 0; m < 4; ++m) { const int rl = ai * HALF + wr * 64 + m * 16 + fr;
                if (rl < u.cnt) { const int tk = mt[rl]; unsigned char* rowp = ((tk & 1) ? y1 : y0) + (size_t)(tk >> 1) * DM + u.pn * BM + wc * 32 + 8 * fq;
#pragma unroll
                    for (int bj = 0; bj < 2; ++bj) { const f32x4 v0 = acc[ai][bj][m][0] * sc, v1 = acc[ai][bj][m][1] * sc;
                        *(u32x2*)(rowp + bj * HALF) = (u32x2){pk4_fp8(v0[0], v0[1], v0[2], v0[3]), pk4_fp8(v1[0], v1[1], v1[2], v1[3])}; } } }
    }
};
#undef ACC_T
}

namespace att {
typedef short v4i16_t __attribute__((ext_vector_type(4)));
__device__ __forceinline__ s16x4 vtr(const LAS char* p) { return __builtin_bit_cast(s16x4, __builtin_amdgcn_ds_read_tr16_b64_v4i16((LAS v4i16_t*)p)); }
__device__ __forceinline__ bf16x8 vfrag(const LAS char* p) { const s16x4 lo = vtr(p), hi = vtr(p + 512); return (bf16x8){lo[0], lo[1], lo[2], lo[3], hi[0], hi[1], hi[2], hi[3]}; }
__device__ __forceinline__ bf16x8 pfrag(const f32x16& p, int b) {
    u32x4 w; w.x = cvt_pk_bf16(p[b], p[b + 1]); w.y = cvt_pk_bf16(p[b + 2], p[b + 3]); w.z = cvt_pk_bf16(p[b + 4], p[b + 5]); w.w = cvt_pk_bf16(p[b + 6], p[b + 7]); return __builtin_bit_cast(bf16x8, w); }

__device__ __forceinline__ void glds16(const void* gsrc, unsigned lds_dst) { unsigned keep;
    asm volatile("s_mov_b32 %0, m0\n\ts_mov_b32 m0, %2\n\ts_nop 0\n\tglobal_load_lds_dwordx4 %1, off\n\ts_mov_b32 m0, %0" : "=&s"(keep) : "v"(gsrc), "s"(lds_dst) : "memory"); }
#define WAIT_BAR(N) asm volatile("s_waitcnt vmcnt(" #N ") lgkmcnt(0)\n\ts_barrier" ::: "memory")
#define MX3(a, b, c) __builtin_fmaxf(__builtin_fmaxf((a), (b)), (c))
__device__ __forceinline__ float fadd_s(float a, float b) { float r; asm("v_add_f32_e32 %0, %1, %2" : "=v"(r) : "v"(a), "v"(b)); return r; }
constexpr float THR = 8.0f, PZERO = -151.0f;

template <int NDB>
__device__ __forceinline__ void tile64(const LAS char* kbuf, const LAS char* vbuf, const int (&koff)[4], const bf16x8 (&qr)[4], float slope2, float u, float s32,
                                       bool causal, int kvrel0, int qrel, float& mref, float& l, f32x16 (&o)[NDB], LAS float* wsf, int r32, int hi, int lane) {
    bf16x8 kf[8];
#pragma unroll
    for (int s = 0; s < 4; ++s) { kf[2 * s] = *(const LAS bf16x8*)(kbuf + koff[s]); kf[2 * s + 1] = *(const LAS bf16x8*)(kbuf + koff[s] + 4096); }
    f32x16 p0, p1;
    { const float u0 = __builtin_fmaf(slope2, (float)(4 * hi), u), u1 = u0 + s32;
#pragma unroll
      for (int r = 0; r < 16; ++r) { const float cr = (float)((r & 3) + 8 * (r >> 2)); p0[r] = __builtin_fmaf(slope2, cr, u0); p1[r] = __builtin_fmaf(slope2, cr, u1); } }
    __builtin_amdgcn_sched_barrier(0);
#pragma unroll
    for (int s = 0; s < 4; ++s) {
        p0 = __builtin_amdgcn_mfma_f32_32x32x16_bf16(kf[2 * s], qr[s], p0, 0, 0, 0);
        p1 = __builtin_amdgcn_mfma_f32_32x32x16_bf16(kf[2 * s + 1], qr[s], p1, 0, 0, 0);
    }
    const LAS char* vp = vbuf + ((lane >> 4) & 1) * 32 + (lane & 3) * 8 + (4 * hi + ((lane & 15) >> 2)) * 64;
    bf16x8 vf[NDB][4];
#pragma unroll
    for (int ks = 0; ks < 4; ++ks) vf[0][ks] = vfrag(vp + ks * 1024);
    __builtin_amdgcn_sched_barrier(0);
    if (causal) {
#pragma unroll
        for (int r = 0; r < 16; ++r) { const int kv = kvrel0 + crow(r, hi); if (kv > qrel) p0[r] = -INFINITY; if (kv + 32 > qrel) p1[r] = -INFINITY; }
    }
    float ra = MX3(p0[0], p0[1], p1[0]), rb = MX3(p0[2], p0[3], p1[1]); ra = MX3(ra, p1[2], p1[3]);
#pragma unroll
    for (int r = 4; r < 16; r += 4) { ra = MX3(ra, p0[r], p0[r + 1]); rb = MX3(rb, p0[r + 2], p0[r + 3]); ra = MX3(ra, p1[r], p1[r + 1]); rb = MX3(rb, p1[r + 2], p1[r + 3]); }
    const float rm = xhalf_max(fmaxf(ra, rb));
    if (__all(rm < PZERO)) return;
    if (__any(rm > THR)) {
        const float dl = fmaxf(rm, 0.f); mref += dl;
#pragma unroll
        for (int r = 0; r < 16; ++r) { p0[r] -= dl; p1[r] -= dl; }
        const float f = __builtin_amdgcn_exp2f(-dl); l *= f;
        if (hi == 0) wsf[r32] = f;
        LDS_WAIT();
#pragma unroll
        for (int r = 0; r < 16; ++r) { const float fr_ = wsf[crow(r, hi)];
#pragma unroll
            for (int d = 0; d < NDB; ++d) o[d][r] *= fr_; }
    }
    {
    float sum = 0.f;
#pragma unroll
    for (int r = 0; r < 16; ++r) { p0[r] = __builtin_amdgcn_exp2f(p0[r]); p1[r] = __builtin_amdgcn_exp2f(p1[r]); }
    asm volatile("s_nop 1" : "+v"(p0), "+v"(p1));
    float sb = 0.f;
#pragma unroll
    for (int r = 0; r < 16; ++r) { sum = fadd_s(sum, p0[r]); sb = fadd_s(sb, p1[r]); }
    l += sum + sb; }
    const bf16x8 pa0 = pfrag(p0, 0), pa1 = pfrag(p0, 8), pa2 = pfrag(p1, 0), pa3 = pfrag(p1, 8);
    __builtin_amdgcn_sched_barrier(0);
#pragma unroll
    for (int d = 0; d < NDB; ++d) {
        if (d + 1 < NDB) {
#pragma unroll
            for (int ks = 0; ks < 4; ++ks) vf[d + 1][ks] = vfrag(vp + (d + 1) * 4096 + ks * 1024);
        }
        __builtin_amdgcn_sched_barrier(0);
        o[d] = __builtin_amdgcn_mfma_f32_32x32x16_bf16(pa0, vf[d][0], o[d], 0, 0, 0);
        o[d] = __builtin_amdgcn_mfma_f32_32x32x16_bf16(pa1, vf[d][1], o[d], 0, 0, 0);
        o[d] = __builtin_amdgcn_mfma_f32_32x32x16_bf16(pa2, vf[d][2], o[d], 0, 0, 0);
        o[d] = __builtin_amdgcn_mfma_f32_32x32x16_bf16(pa3, vf[d][3], o[d], 0, 0, 0);
        __builtin_amdgcn_sched_barrier(0);
    }
}

__device__ __forceinline__ void moba_unit(const bf16_t* __restrict__ proj, const LAS float* ksl, bf16_t* __restrict__ mixed, float* __restrict__ ssqA,
                                          int b, int h, int own, LAS char* lds, LAS float* wsf_all) {
    const int tid = threadIdx.x, lane = tid & 63, r32 = lane & 31, hi = lane >> 5, w = __builtin_amdgcn_readfirstlane(tid >> 6);
    LAS float* wsf = wsf_all + w * 64;
    const unsigned lds0 = (unsigned)(size_t)lds;
    const size_t rowb = (size_t)b * SEQ; const int q0 = own * 256;
    const int NT = 4 * (own + 1);
    const int krow = 8 * w + (lane >> 3);
    const bf16_t* hb = proj + ((size_t)(b * 8 + h) * SEQ) * 64;
    const bf16_t* ksrc = hb + pg8::PREG + krow * 64 + (((lane & 7) ^ ((krow >> 1) & 7)) << 3);
    const bf16_t* vsrc = hb + 2 * pg8::PREG + (16 * (w & 3) + (lane >> 2)) * 64 + (w >> 2) * 32 + (lane & 3) * 8;
    const unsigned dst0 = lds0 + w * 1024;
#define MOBA_DMA(s_) do { const int T_ = NT - 1 - (s_); const unsigned d_ = (unsigned)__builtin_amdgcn_readfirstlane(dst0 + ((s_) & 3) * 16384); \
        glds16(ksrc + T_ * 4096, d_); glds16(vsrc + T_ * 4096, d_ + 8192); } while (0)
    MOBA_DMA(0); MOBA_DMA(1); MOBA_DMA(2);
    const bf16_t* Qp = hb + (q0 + 32 * w + r32) * 64;
    bf16x8 qr[4];
#pragma unroll
    for (int s = 0; s < 4; ++s) qr[s] = *(const bf16x8*)(Qp + 16 * s + 8 * hi);
#pragma unroll
    for (int s = 0; s < 4; ++s) asm volatile("" : "+v"(qr[s]));
    int selmask = 0xff;
    if (own > 3) {
        float t1 = -INFINITY, t2 = -INFINITY, t3 = -INFINITY; int i1 = 0, i2 = 0, i3 = 0;
#pragma unroll 1
        for (int n = 0; n < own; ++n) {
            const LAS float* k0 = ksl + n * 64 + 8 * hi;
            float a = 0.f;
#pragma unroll
            for (int s = 0; s < 4; ++s) {
                const f32x4 x0 = *(const LAS f32x4*)(k0 + 16 * s), x1 = *(const LAS f32x4*)(k0 + 16 * s + 4);
                const u32x4 qq = __builtin_bit_cast(u32x4, qr[s]);
                a += bf_lo(qq.x) * x0[0] + bf_hi(qq.x) * x0[1] + bf_lo(qq.y) * x0[2] + bf_hi(qq.y) * x0[3] + bf_lo(qq.z) * x1[0] + bf_hi(qq.z) * x1[1] + bf_lo(qq.w) * x1[2] + bf_hi(qq.w) * x1[3];
            }
            a = xhalf_sum(a);
            const bool g1 = a > t1, g2 = a > t2, g3 = a > t3;
            t3 = g2 ? t2 : (g3 ? a : t3); i3 = g2 ? i2 : (g3 ? n : i3);
            t2 = g1 ? t1 : (g2 ? a : t2); i2 = g1 ? i1 : (g2 ? n : i2);
            t1 = g1 ? a : t1;             i1 = g1 ? n : i1;
        }
        selmask = (1 << i1) | (1 << i2) | (1 << i3);
    }
    const float slope2 = __builtin_amdgcn_exp2f(-(float)(h + 1)) * LOG2E;
    int koff[4];
#pragma unroll
    for (int s = 0; s < 4; ++s) koff[s] = r32 * 128 + (((2 * s + hi) ^ ((r32 >> 1) & 7)) << 4);
    float mref = 0.f, l = 0.f; f32x16 o[2]; o[0] = f32x16{}; o[1] = f32x16{};
    const int qrel = 32 * w + r32;
    for (int s = 0; s < NT; ++s) {
        const int T = NT - 1 - s, rem = NT - 1 - s;
        if (rem >= 2) WAIT_BAR(4); else if (rem == 1) WAIT_BAR(2); else WAIT_BAR(0);
        if (s + 3 < NT) MOBA_DMA(s + 3);
        const int jb = T - 4 * own;
        const bool skip = jb >= 0 && (64 * jb > 32 * w + 31);
        if (!skip) {
            const LAS char* buf = lds + (s & 3) * 16384;
            const bool sel = jb >= 0 || ((selmask >> (T >> 2)) & 1);
            const float u = sel ? (slope2 * (float)(64 * T - q0 - qrel) - mref) : -INFINITY;
            tile64<2>(buf, buf + 8192, koff, qr, slope2, u, 32.f * slope2, jb >= 0 && (64 * jb + 63 > 32 * w), 64 * jb, qrel, mref, l, o, wsf, r32, hi, lane);
        }
    }
#undef MOBA_DMA
    WAIT_BAR(0);
    l = xhalf_sum(l);
    if (hi == 0) wsf[32 + r32] = 1.0f / l;
    LDS_WAIT();
    LAS float* stg = (LAS float*)(lds + w * 8704);
#pragma unroll
    for (int r = 0; r < 16; ++r) { const int orow = crow(r, hi); const float il = wsf[32 + orow];
        stg[orow * 68 + r32] = o[0][r] * il; stg[orow * 68 + 32 + r32] = o[1][r] * il; }
    LDS_WAIT();
#pragma unroll
    for (int i = 0; i < 4; ++i) { const int row = 8 * i + (lane >> 3), ch = lane & 7; const LAS float* sp = stg + row * 68 + ch * 8;
      const f32x4 v0 = *(const LAS f32x4*)sp, v1 = *(const LAS f32x4*)(sp + 4);
      float q = (v0[0] * v0[0] + v0[1] * v0[1]) + (v0[2] * v0[2] + v0[3] * v0[3]) + (v1[0] * v1[0] + v1[1] * v1[1]) + (v1[2] * v1[2] + v1[3] * v1[3]);
      q += __shfl_xor(q, 1); q += __shfl_xor(q, 2); q += __shfl_xor(q, 4);
      const size_t grow = rowb + q0 + 32 * w + row;
      if (ch == 0) ssqA[grow * 8 + h] = q;
      *(u32x4*)(mixed + grow * DM + h * 64 + ch * 8) = pg8::pack8(v0, v1); }
    asm volatile("s_waitcnt lgkmcnt(0)\n\ts_barrier" ::: "memory");
}

__device__ __forceinline__ void diff_unit(const bf16_t* __restrict__ proj, bf16_t* __restrict__ mixed, const float* __restrict__ subln, float lam,
                                          int b, int h, int qt, LAS char* lds, LAS float* wsf_all) {
    const int tid = threadIdx.x, lane = tid & 63, r32 = lane & 31, hi = lane >> 5, w = __builtin_amdgcn_readfirstlane(tid >> 6), c = w >> 2, rg = w & 3;
    LAS float* wsf = wsf_all + w * 64;
    const unsigned lds0 = (unsigned)(size_t)lds;
    const size_t rowb = (size_t)b * SEQ; const int q0 = qt * 128;
    const int NT = 2 * (qt + 1);
    const int krow = 8 * w + (lane >> 3);
    const bf16_t* hb = proj + ((size_t)(b * 4 + h) * SEQ) * 128;
    const bf16_t* k0src = hb + 4 * pg8::PREG + krow * 64 + (((lane & 7) ^ ((krow >> 1) & 7)) << 3);
    const bf16_t* v0src = hb + 5 * pg8::PREG + (16 * (w & 3) + (lane >> 2)) * 128 + (w >> 2) * 32 + (lane & 3) * 8;
    const unsigned dst0 = lds0 + w * 1024;
#define DIFF_DMA(s_) do { const int T_ = NT - 1 - (s_); const unsigned d_ = (unsigned)__builtin_amdgcn_readfirstlane(dst0 + ((s_) & 3) * 32768); \
        glds16(k0src + T_ * 4096, d_); glds16(k0src + SEQ * 64 + T_ * 4096, d_ + 8192); glds16(v0src + T_ * 8192, d_ + 16384); glds16(v0src + 64 + T_ * 8192, d_ + 24576); } while (0)
    DIFF_DMA(0); DIFF_DMA(1); if (NT > 2) DIFF_DMA(2);
    const bf16_t* Qp = hb + 3 * pg8::PREG + (size_t)c * (SEQ * 64) + (q0 + 32 * rg + r32) * 64;
    bf16x8 qr[4];
#pragma unroll
    for (int s = 0; s < 4; ++s) qr[s] = *(const bf16x8*)(Qp + 16 * s + 8 * hi);
#pragma unroll
    for (int s = 0; s < 4; ++s) asm volatile("" : "+v"(qr[s]));
    const float slope2 = __builtin_amdgcn_exp2f(-2.0f * (float)(h + 1)) * LOG2E;
    int koff[4];
#pragma unroll
    for (int s = 0; s < 4; ++s) koff[s] = r32 * 128 + (((2 * s + hi) ^ ((r32 >> 1) & 7)) << 4);
    float mref = 0.f, l = 0.f; f32x16 o[4];
#pragma unroll
    for (int d = 0; d < 4; ++d) o[d] = f32x16{};
    const int qrel = 32 * rg + r32;
    for (int s = 0; s < NT; ++s) {
        const int T = NT - 1 - s, rem = NT - 1 - s;
        if (rem >= 2) WAIT_BAR(8); else if (rem == 1) WAIT_BAR(4); else WAIT_BAR(0);
        if (s + 3 < NT) DIFF_DMA(s + 3);
        const int jb = T - 2 * qt;
        const bool skip = jb >= 0 && (64 * jb > 32 * rg + 31);
        if (!skip) {
            const LAS char* buf = lds + (s & 3) * 32768;
            const float u = slope2 * (float)(64 * T - q0 - qrel) - mref;
            tile64<4>(buf + c * 8192, buf + 16384, koff, qr, slope2, u, 32.f * slope2, jb >= 0 && (64 * jb + 63 > 32 * rg), 64 * jb, qrel, mref, l, o, wsf, r32, hi, lane);
        }
    }
#undef DIFF_DMA
    WAIT_BAR(0);
    l = xhalf_sum(l);
    if (hi == 0) wsf[32 + r32] = (c == 1 ? lam : 1.0f) / l;
    LDS_WAIT();
    LAS float* Lb = (LAS float*)lds;
    if (c == 1) {
#pragma unroll
        for (int r = 0; r < 16; ++r) { const int orow = 32 * rg + crow(r, hi); const float il = wsf[32 + crow(r, hi)];
#pragma unroll
            for (int d = 0; d < 4; ++d) Lb[orow * 132 + 32 * d + r32] = o[d][r] * il; }
    }
    WAIT_BAR(0);
    if (c == 0) {
#pragma unroll
        for (int r = 0; r < 16; ++r) { const int orow = 32 * rg + crow(r, hi); const float il = wsf[32 + crow(r, hi)];
#pragma unroll
            for (int d = 0; d < 4; ++d) { const float v = o[d][r] * il - Lb[orow * 132 + 32 * d + r32]; Lb[orow * 132 + 32 * d + r32] = v; } }
    }
    WAIT_BAR(0);
    { const int ch = tid & 15; const f32x4 g0 = *(const f32x4*)(subln + ch * 8), g1 = *(const f32x4*)(subln + ch * 8 + 4);
#pragma unroll
      for (int i = 0; i < 4; ++i) { const int row = (tid >> 4) + 32 * i; const LAS float* sp = Lb + row * 132 + ch * 8;
        const f32x4 v0 = *(const LAS f32x4*)sp, v1 = *(const LAS f32x4*)(sp + 4);
        float q = (v0[0] * v0[0] + v0[1] * v0[1]) + (v0[2] * v0[2] + v0[3] * v0[3]) + (v1[0] * v1[0] + v1[1] * v1[1]) + (v1[2] * v1[2] + v1[3] * v1[3]);
        q += __shfl_xor(q, 1); q += __shfl_xor(q, 2); q += __shfl_xor(q, 4); q += __shfl_xor(q, 8);
        const float rs = 0.8f / sqrtf(q * (1.0f / 128.0f) + RMS_EPS);
        *(u32x4*)(mixed + (rowb + q0 + row) * DM + 512 + h * 128 + ch * 8) = pg8::pack8(v0 * g0 * rs, v1 * g1 * rs); } }
    asm volatile("s_waitcnt lgkmcnt(0)\n\ts_barrier" ::: "memory");
}

__device__ __forceinline__ void cross_unit(const bf16_t* __restrict__ qmem, const bf16_t* __restrict__ kvmem, unsigned char* __restrict__ omem, int b, int mh, int qt, LAS char* lds, LAS float* wsf_all) {
    const int tid = threadIdx.x, lane = tid & 63, r32 = lane & 31, hi = lane >> 5, w = __builtin_amdgcn_readfirstlane(tid >> 6);
    LAS float* wsf = wsf_all + w * 64;
    const unsigned lds0 = (unsigned)(size_t)lds;
    const size_t qrow = (size_t)b * SEQ + qt * 256 + 32 * w + r32;
    const bf16_t* Qp = qmem + qrow * DM + mh * 256;
    const bf16_t* kbase = kvmem + (size_t)b * MEMLEN * 2048 + mh * 256;
    const bf16_t* ksrc0; { const int row = 2 * w + (lane >> 5); ksrc0 = kbase + (size_t)row * 2048 + (((lane & 31) ^ (row & 15)) << 3); }
    const bf16_t* vsrc = kbase + 1024 + (size_t)(16 * (w & 3) + (lane >> 2)) * 2048 + (w >> 2) * 32 + (lane & 3) * 8;
    const unsigned dst0 = lds0 + w * 1024;
#define CROSS_DMA(st_) do { const unsigned d_ = (unsigned)__builtin_amdgcn_readfirstlane(dst0 + ((st_) & 3) * 32768); \
        if ((st_) < 4) { _Pragma("unroll") for (int j_ = 0; j_ < 4; ++j_) glds16(ksrc0 + (size_t)((st_) * 64 + 16 * j_) * 2048, d_ + j_ * 8192); } \
        else { _Pragma("unroll") for (int j_ = 0; j_ < 4; ++j_) glds16(vsrc + (size_t)((st_) - 4) * 64 * 2048 + j_ * 64, d_ + j_ * 8192); } } while (0)
    CROSS_DMA(0); CROSS_DMA(1); CROSS_DMA(2);
    bf16x8 qr[16];
#pragma unroll
    for (int s = 0; s < 16; ++s) qr[s] = *(const bf16x8*)(Qp + 16 * s + 8 * hi);
#pragma unroll
    for (int s = 0; s < 16; ++s) asm volatile("" : "+v"(qr[s]));
    int koff[8];
#pragma unroll
    for (int s = 0; s < 8; ++s) koff[s] = r32 * 512 + (((2 * s + hi) ^ (r32 & 15)) << 4);
    f32x16 p[8];
#pragma unroll
    for (int kt = 0; kt < 4; ++kt) {
        WAIT_BAR(8);
        CROSS_DMA(kt + 3);
        const LAS char* kp = lds + (kt & 3) * 32768;
        f32x16 a0 = f32x16{}, a1 = f32x16{};
#pragma unroll
        for (int s = 0; s < 16; ++s) {
            const bf16x8 k0 = *(const LAS bf16x8*)(kp + koff[s & 7] + (s >> 3) * 256), k1 = *(const LAS bf16x8*)(kp + koff[s & 7] + (s >> 3) * 256 + 16384);
            a0 = __builtin_amdgcn_mfma_f32_32x32x16_bf16(k0, qr[s], a0, 0, 0, 0);
            a1 = __builtin_amdgcn_mfma_f32_32x32x16_bf16(k1, qr[s], a1, 0, 0, 0);
            if ((s & 3) == 3) __builtin_amdgcn_sched_barrier(0);
        }
        p[2 * kt] = a0; p[2 * kt + 1] = a1;
    }
    float m = p[0][0];
#pragma unroll
    for (int i = 0; i < 8; ++i)
#pragma unroll
        for (int r = 0; r < 16; ++r) m = fmaxf(m, p[i][r]);
    m = xhalf_max(m);
    float l = 0.f;
#pragma unroll
    for (int i = 0; i < 8; ++i)
#pragma unroll
        for (int r = 0; r < 16; ++r) { p[i][r] = __builtin_amdgcn_exp2f(p[i][r] - m); l += p[i][r]; }
    l = xhalf_sum(l);
    bf16x8 pa[16];
#pragma unroll
    for (int i = 0; i < 8; ++i) { pa[2 * i] = pfrag(p[i], 0); pa[2 * i + 1] = pfrag(p[i], 8); }
    f32x16 o[8];
#pragma unroll
    for (int d = 0; d < 8; ++d) o[d] = f32x16{};
    const int vlane = ((lane >> 4) & 1) * 32 + (lane & 3) * 8 + (4 * hi + ((lane & 15) >> 2)) * 64;
#pragma unroll
    for (int vt = 0; vt < 4; ++vt) {
        if (vt == 0) { WAIT_BAR(8); CROSS_DMA(7); } else if (vt == 1) WAIT_BAR(8); else if (vt == 2) WAIT_BAR(4); else WAIT_BAR(0);
        const LAS char* vp = lds + ((4 + vt) & 3) * 32768 + vlane;
#pragma unroll
        for (int d = 0; d < 8; ++d) {
#pragma unroll
            for (int ks = 0; ks < 4; ++ks) o[d] = __builtin_amdgcn_mfma_f32_32x32x16_bf16(pa[4 * vt + ks], vfrag(vp + d * 4096 + ks * 1024), o[d], 0, 0, 0);
            if (d & 1) __builtin_amdgcn_sched_barrier(0);
        }
    }
#undef CROSS_DMA
    WAIT_BAR(0);
    if (hi == 0) wsf[32 + r32] = 1.0f / l;
    LDS_WAIT();
    LAS unsigned short* stg = (LAS unsigned short*)(lds + w * 8704);
    float il[16];
#pragma unroll
    for (int r = 0; r < 16; ++r) il[r] = wsf[32 + crow(r, hi)];
#pragma unroll
    for (int hf = 0; hf < 2; ++hf) {
#pragma unroll
        for (int r = 0; r < 16; ++r) { const int orow = crow(r, hi);
#pragma unroll
            for (int d = 0; d < 4; ++d) stg[orow * 136 + 32 * d + r32] = (unsigned short)(cvt_pk_bf16(o[4 * hf + d][r] * il[r], 0.f) & 0xffffu); }
        LDS_WAIT();
#pragma unroll
        for (int i = 0; i < 8; ++i) { const int row = (lane >> 4) + 4 * i, ch = lane & 15;
          const u32x4 ob = *(const LAS u32x4*)(stg + row * 136 + ch * 8);
          *(u32x2*)(omem + ((size_t)b * SEQ + qt * 256 + 32 * w + row) * DM + mh * 256 + hf * 128 + ch * 8) =
              (u32x2){pk4_fp8(bf_lo(ob.x) * SH8, bf_hi(ob.x) * SH8, bf_lo(ob.y) * SH8, bf_hi(ob.y) * SH8), pk4_fp8(bf_lo(ob.z) * SH8, bf_hi(ob.z) * SH8, bf_lo(ob.w) * SH8, bf_hi(ob.w) * SH8)}; }
        LDS_WAIT();
    }
    asm volatile("s_waitcnt lgkmcnt(0)\n\ts_barrier" ::: "memory");
}
}

typedef GAS unsigned gu32;
#define RLX_AGENT __ATOMIC_RELAXED, __HIP_MEMORY_SCOPE_AGENT
#define XB_TMO      128
#define XB_XCNT(j)  (256  + 64 * (j))
#define XB_XSUB(j)  (1280 + 64 * (j))
#define XB_XGEN(j)  (2304 + 64 * (j))
#define XB_TOP      3328
#define XB_TOPGEN   3392
#define XCD_BAR_WORDS 3456
#define XB_SPIN_CAP (1u << 18)
__device__ __forceinline__ unsigned xb_ld(unsigned* p)              { return __hip_atomic_load(p, __ATOMIC_RELAXED, __HIP_MEMORY_SCOPE_AGENT); }
__device__ __forceinline__ unsigned xb_add(unsigned* p, unsigned v) { return __hip_atomic_fetch_add(p, v, __ATOMIC_RELAXED, __HIP_MEMORY_SCOPE_AGENT); }
__device__ __forceinline__ unsigned xb_xcc_id() { return (unsigned)__builtin_amdgcn_s_getreg((3 << 11) | 20) & 0xFu; }
#define XB_SPIN(cond, bar) do { unsigned _sp = 0; while (cond) { __builtin_amdgcn_s_sleep(1); \
    if ((++_sp & 255u) == 0u) { if (xb_ld(&(bar)[XB_TMO])) break; if (_sp > XB_SPIN_CAP) { atomicAdd(&(bar)[XB_TMO], 1u); break; } } } } while (0)
struct XcdBarrier { unsigned* bar; unsigned x; volatile LAS unsigned* st; };
__device__ __forceinline__ XcdBarrier xcd_barrier_post(unsigned* bar, volatile LAS unsigned* st) {
    XcdBarrier b; b.bar = bar; b.x = xb_xcc_id(); b.st = st;
    if (threadIdx.x == 0) (void)xb_add(&bar[XB_XCNT(b.x)], 1u);
    return b;
}
__device__ __forceinline__ void xcd_barrier_complete(unsigned* bar, unsigned x, unsigned& nloc, unsigned& nx) {
    const unsigned G = gridDim.x * gridDim.y * gridDim.z;
    unsigned sum, cnt, mine, sp = 0u;
    for (;;) {
        sum = 0u; cnt = 0u; mine = 0u;
#pragma unroll
        for (unsigned j = 0; j < 16; ++j) { const unsigned c = xb_ld(&bar[XB_XCNT(j)]); sum += c; cnt += (c > 0u) ? 1u : 0u; mine = (j == x) ? c : mine; }
        if (sum == G) break;
        __builtin_amdgcn_s_sleep(1);
        if ((++sp & 255u) == 0u) { if (xb_ld(&bar[XB_TMO])) break; if (sp > XB_SPIN_CAP) { atomicAdd(&bar[XB_TMO], 1u); break; } }
    }
    nloc = mine > 0u ? mine : 1u; nx = cnt > 0u ? cnt : 1u;
}
__device__ __forceinline__ void xcd_barrier(const XcdBarrier& b) {
    asm volatile("s_waitcnt vmcnt(0)" ::: "memory");
    __syncthreads();
    if (threadIdx.x == 0) {
        unsigned* bar = b.bar;
        __builtin_amdgcn_s_waitcnt(0);
        unsigned nloc = b.st[0], nx = b.st[1];
        if (nloc == 0u) { xcd_barrier_complete(bar, b.x, nloc, nx); b.st[0] = nloc; b.st[1] = nx; }
        const unsigned old = xb_add(&bar[XB_XSUB(b.x)], 1u);
        const unsigned gen = old / nloc;
        if (old + 1u == (gen + 1u) * nloc) {
            __builtin_amdgcn_fence(__ATOMIC_RELEASE, "agent");
            asm volatile("s_waitcnt vmcnt(0)" ::: "memory");
            const unsigned og = xb_add(&bar[XB_TOP], 1u);
            const unsigned tg = og / nx;
            if (og + 1u == (tg + 1u) * nx) xb_add(&bar[XB_TOPGEN], 1u);
            else XB_SPIN(xb_ld(&bar[XB_TOPGEN]) == tg, bar);
            __builtin_amdgcn_fence(__ATOMIC_ACQUIRE, "agent");
            xb_add(&bar[XB_XGEN(b.x)], 1u);
            asm volatile("s_waitcnt vmcnt(0)" ::: "memory");
        } else {
            XB_SPIN(xb_ld(&bar[XB_XGEN(b.x)]) == gen, bar);
            __builtin_amdgcn_fence(__ATOMIC_ACQUIRE, "agent");
            asm volatile("s_waitcnt vmcnt(0)" ::: "memory");
        }
    }
    __syncthreads();
}

constexpr int NWAVES = 8;
__device__ __forceinline__ void p0_transpose_item(const float* W, int K, int N, bf16_t* WT, int rmode, const float* gain, int gain_n, LAS float* scr, int item, int lane) {
    const int nblk = N / 32, kb = item / nblk, nb = item % nblk, k0 = 64 * kb, n0 = 32 * nb;
    f32x4 v[8]; float gv[8];
#pragma unroll
    for (int i = 0; i < 8; ++i) { const int kk = 8 * i + (lane >> 3); v[i] = *(const f32x4*)(W + (size_t)(k0 + kk) * N + n0 + 4 * (lane & 7)); gv[i] = (gain && (k0 + kk) < gain_n) ? gain[k0 + kk] : 1.0f; }
#pragma unroll
    for (int i = 0; i < 8; ++i) { LAS float* d = scr + (8 * i + (lane >> 3)) * 33 + 4 * (lane & 7); d[0] = v[i][0] * gv[i]; d[1] = v[i][1] * gv[i]; d[2] = v[i][2] * gv[i]; d[3] = v[i][3] * gv[i]; }
    LDS_WAIT(); asm volatile("" ::: "memory");
    const int c = lane & 7;
#pragma unroll
    for (int j = 0; j < 4; ++j) { const int n = (lane >> 3) + 8 * j; const LAS float* s = scr + (8 * c) * 33 + n;
        u32x4 o; o.x = cvt_pk_bf16(s[0 * 33], s[1 * 33]); o.y = cvt_pk_bf16(s[2 * 33], s[3 * 33]); o.z = cvt_pk_bf16(s[4 * 33], s[5 * 33]); o.w = cvt_pk_bf16(s[6 * 33], s[7 * 33]);
        const int nn = n0 + n; const int row = rmode == 0 ? nn : ((nn >> 7) * 256 + (nn & 127) + (rmode == 2 ? 128 : 0));
        *(u32x4*)(WT + (size_t)row * K + k0 + 8 * c) = o; }
    LDS_WAIT(); asm volatile("" ::: "memory");
}
__device__ __forceinline__ void p0_transpose_item8(const float* W, int K, int N, unsigned char* WT, int rmode, const float* gain, float scale, LAS float* scr, int item, int lane) {
    const int nblk = N / 32, kb = item / nblk, nb = item % nblk, k0 = 64 * kb, n0 = 32 * nb;
    f32x4 v[8]; float gv[8];
#pragma unroll
    for (int i = 0; i < 8; ++i) { const int kk = 8 * i + (lane >> 3); v[i] = *(const f32x4*)(W + (size_t)(k0 + kk) * N + n0 + 4 * (lane & 7)); gv[i] = gain ? gain[k0 + kk] * scale : scale; }
#pragma unroll
    for (int i = 0; i < 8; ++i) { LAS float* d = scr + (8 * i + (lane >> 3)) * 33 + 4 * (lane & 7); d[0] = v[i][0] * gv[i]; d[1] = v[i][1] * gv[i]; d[2] = v[i][2] * gv[i]; d[3] = v[i][3] * gv[i]; }
    LDS_WAIT(); asm volatile("" ::: "memory");
    const int c = lane & 7;
#pragma unroll
    for (int j = 0; j < 4; ++j) { const int n = (lane >> 3) + 8 * j; const LAS float* sp = scr + (8 * c) * 33 + n;
        const u32x2 o = (u32x2){pk4_fp8(sp[0 * 33], sp[1 * 33], sp[2 * 33], sp[3 * 33]), pk4_fp8(sp[4 * 33], sp[5 * 33], sp[6 * 33], sp[7 * 33])};
        const int nn = n0 + n; const int row = rmode == 0 ? nn : ((nn >> 7) * 256 + (nn & 127) + (rmode == 2 ? 128 : 0));
        *(u32x2*)(WT + (size_t)row * K + k0 + 8 * c) = o; }
    LDS_WAIT(); asm volatile("" ::: "memory");
}
template <int RB>
__device__ __forceinline__ void rms_rows_to_bf16(const float* x, const float* gain, bf16_t* o, int row0, int rstride, int nrows, int lane, float* inv_out) {
    f32x4 v[RB][4]; const f32x4* gr = (const f32x4*)gain + lane;
#pragma unroll
    for (int r = 0; r < RB; ++r) { const int row = min(row0 + r * rstride, nrows - 1); const f32x4* xr = (const f32x4*)(x + (size_t)row * DM) + lane;
#pragma unroll
        for (int j = 0; j < 4; ++j) v[r][j] = xr[64 * j]; }
    f32x4 g[4];
#pragma unroll
    for (int j = 0; j < 4; ++j) g[j] = gr[64 * j];
#pragma unroll
    for (int r = 0; r < RB; ++r) { const int row = row0 + r * rstride; float s = 0.f;
#pragma unroll
        for (int j = 0; j < 4; ++j) s += (v[r][j][0] * v[r][j][0] + v[r][j][1] * v[r][j][1]) + (v[r][j][2] * v[r][j][2] + v[r][j][3] * v[r][j][3]);
        const float rms = sqrtf(wave_sum(s) * (1.0f / 1024.0f) + RMS_EPS), rstd = 1.0f / rms;
        if (row < nrows) { if (inv_out && lane == 0) inv_out[row] = rms;
            u32x2* o8 = (u32x2*)(o + (size_t)row * DM) + lane;
#pragma unroll
            for (int j = 0; j < 4; ++j) { const f32x4 y = v[r][j] * g[j] * rstd; u32x2 ov; ov.x = cvt_pk_bf16(y[0], y[1]); ov.y = cvt_pk_bf16(y[2], y[3]); o8[64 * j] = ov; } } }
}
template <int RB>
__device__ __forceinline__ void rms_rows_to_fp8(const float* x, const float* gain, unsigned char* o, int row0, int rstride, int nrows, int lane) {
    f32x4 v[RB][4]; const f32x4* gr = (const f32x4*)gain + lane;
#pragma unroll
    for (int r = 0; r < RB; ++r) { const int row = min(row0 + r * rstride, nrows - 1); const f32x4* xr = (const f32x4*)(x + (size_t)row * DM) + lane;
#pragma unroll
        for (int j = 0; j < 4; ++j) v[r][j] = xr[64 * j]; }
    f32x4 g[4];
#pragma unroll
    for (int j = 0; j < 4; ++j) g[j] = gr[64 * j];
#pragma unroll
    for (int r = 0; r < RB; ++r) { const int row = row0 + r * rstride; float s = 0.f;
#pragma unroll
        for (int j = 0; j < 4; ++j) s += (v[r][j][0] * v[r][j][0] + v[r][j][1] * v[r][j][1]) + (v[r][j][2] * v[r][j][2] + v[r][j][3] * v[r][j][3]);
        const float rstd = 1.0f / sqrtf(wave_sum(s) * (1.0f / 1024.0f) + RMS_EPS);
        if (row < nrows) { unsigned* o4 = (unsigned*)(o + (size_t)row * DM) + lane;
#pragma unroll
            for (int j = 0; j < 4; ++j) { const f32x4 y = v[r][j] * g[j] * rstd; o4[64 * j] = pk4_fp8(y[0], y[1], y[2], y[3]); } } }
}

struct Args { const float* in[25]; float* out; unsigned char* ws; int ph_lo, ph_hi; };
constexpr int NPHASE = 11;

__global__ void __launch_bounds__(NWAVES * 64, 2) hymba_fwd(Args args) {
    extern __shared__ __attribute__((aligned(16))) unsigned char lds_raw[];
    LAS unsigned char* lds = (LAS unsigned char*)lds_raw;
    volatile LAS unsigned* MISC = (volatile LAS unsigned*)(lds + MISC_OFF);
    LAS float* wsf_all = (LAS float*)(lds + MISC_OFF + 1024);
    LAS int* mtab = (LAS int*)(lds + MISC_OFF + 4096);
    const int tid = threadIdx.x, lane = tid & 63, wave = __builtin_amdgcn_readfirstlane(tid >> 6);
    const int G = gridDim.x; const int bx = blockIdx.x; const int vcu = (G % 8 == 0) ? (bx % 8) * (G / 8) + bx / 8 : bx;
    unsigned char* ws = args.ws;
    unsigned* ctl = (unsigned*)(ws + WS_CTL);
#pragma unroll
    for (int u = 0; u < (LDS_BYTES - MISC_OFF) / 16 / (NWAVES * 64); ++u) ((LAS u32x4*)(lds + MISC_OFF))[tid + u * NWAVES * 64] = (u32x4){0u, 0u, 0u, 0u};
    __syncthreads();
    XcdBarrier bar = xcd_barrier_post(ctl + CW_BAR, MISC + 8);
    const int lo = args.ph_lo, hi = args.ph_hi;
#ifndef PHMASK
#define PHMASK 0x7ff
#endif
#define IN(k) (((PHMASK >> (k)) & 1) && lo <= (k) && (k) < hi)
#define SEAM(k) do { if (IN(k) && IN((k) + 1)) xcd_barrier(bar); } while (0)
    const float* x = args.in[0]; const float* mem = args.in[1]; const float* norm_mix = args.in[2]; const float* w_in = args.in[3];
    const float* lq1 = args.in[4]; const float* lk1 = args.in[5]; const float* lq2 = args.in[6]; const float* lk2 = args.in[7];
    const float* diff_subln = args.in[8]; const float* norm_moba_out = args.in[9]; const float* w_out = args.in[10];
    const float* norm_mem_q = args.in[11]; const float* norm_mem_kv = args.in[12]; const float* w_mem_q = args.in[13]; const float* w_mem_kv = args.in[14]; const float* w_mem_o = args.in[15];
    const float* norm_ffn = args.in[16]; const float* w_rg = args.in[17]; const float* b_rg = args.in[18]; const float* w_re = args.in[19]; const float* b_re = args.in[20];
    const float* w_gate = args.in[21]; const float* w_up = args.in[22]; const float* w_down = args.in[23]; const float* norm_final = args.in[24];
    bf16_t* WinT = (bf16_t*)(ws + WS_WIN); bf16_t* WoutT = (bf16_t*)(ws + WS_WOUT); unsigned char* Wq8 = ws + WS_WQ; unsigned char* Wkv8 = ws + WS_WKV;
    unsigned char* Wo8 = ws + WS_WO; bf16_t* WrT = (bf16_t*)(ws + WS_WR); unsigned char* Wgu8 = ws + WS_WGU; unsigned char* Wd8 = ws + WS_WD;
    unsigned char* memn8 = ws + WS_MEMN; bf16_t* kvmem = (bf16_t*)(ws + WS_KVMEM);
    float* kms = (float*)(ws + WS_KMS); float* ssqA = (float*)(ws + WS_SSQA); float* ssq1 = (float*)(ws + WS_SSQ1); float* ssq2 = (float*)(ws + WS_SSQ2);
    int* rowtok = (int*)(ws + WS_ROWTOK); float* roww = (float*)(ws + WS_ROWW); float* rowrstd = (float*)(ws + WS_ROWRSTD);
    bf16_t* hn = (bf16_t*)(ws + WS_R0); bf16_t* mixed = (bf16_t*)(ws + WS_H2); float* invrx = (float*)(ws + WS_INVRX);
     unsigned char* y0 = ws + WS_R0 + 64 * MiB;
    bf16_t* h1 = (bf16_t*)(ws + WS_H1); unsigned char* y1 = ws + WS_H1; bf16_t* h2 = (bf16_t*)(ws + WS_H2);
    bf16_t* proj = (bf16_t*)(ws + WS_BIG); bf16_t* qmem = (bf16_t*)(ws + WS_QMEM); unsigned char* omem8 = ws + WS_OMEM; unsigned char* h1f8 = ws + WS_BIG + 256 * MiB; unsigned char* Hid8 = ws + WS_HID; unsigned char* h2f8 = ws + WS_R0;
    unsigned* ecnt = ctl + CW_ECNT;

    if (IN(0)) {
        LAS float* scr = (LAS float*)(lds + wave * 16384);
        const int gw = vcu * NWAVES + wave, NGW = G * NWAVES;
        constexpr int I_IN = 16 * 96, I_SQ = 16 * 32, I_KV = 16 * 64, I_GU = 16 * 16, I_DN = 8 * 32;
        constexpr int NITEMS = I_IN + 3 * I_SQ + I_KV + 32 + NEXP * (2 * I_GU + I_DN);
        for (int it = gw; it < NITEMS; it += NGW) {
            int r = it;
            if (r < I_IN) { p0_transpose_item(w_in, 1024, 3072, WinT, 0, nullptr, 0, scr, r, lane); continue; } r -= I_IN;
            if (r < I_SQ) { p0_transpose_item(w_out, 1024, 1024, WoutT, 0, norm_moba_out, 512, scr, r, lane); continue; } r -= I_SQ;
            if (r < I_SQ) { p0_transpose_item8(w_mem_q, 1024, 1024, Wq8, 0, norm_mem_q, SW8, scr, r, lane); continue; } r -= I_SQ;
            if (r < I_KV) { p0_transpose_item8(w_mem_kv, 1024, 2048, Wkv8, 0, nullptr, SW8, scr, r, lane); continue; } r -= I_KV;
            if (r < I_SQ) { p0_transpose_item8(w_mem_o, 1024, 1024, Wo8, 0, nullptr, SW8, scr, r, lane); continue; } r -= I_SQ;
            if (r < 32) {
                const int k0 = (r & 15) * 64;
                if (r < 16) { for (int n = 0; n < 4; ++n) { const int k = k0 + lane; WrT[(size_t)n * 1024 + k] = (bf16_t)(cvt_pk_bf16(w_rg[(size_t)k * 4 + n] * norm_ffn[k], 0.f) & 0xffffu); } }
                else { for (int n = 0; n < 32; ++n) { const int k = k0 + lane; WrT[(size_t)(4 + n) * 1024 + k] = (bf16_t)(cvt_pk_bf16(w_re[(size_t)k * 32 + n] * norm_ffn[k], 0.f) & 0xffffu); } }
                continue; } r -= 32;
            const int per = 2 * I_GU + I_DN, e = r / per; r -= e * per;
            if (r < I_GU) { p0_transpose_item8(w_gate + (size_t)e * 1024 * 512, 1024, 512, Wgu8 + (size_t)e * 1024 * 1024, 1, norm_ffn, SW8, scr, r, lane); continue; } r -= I_GU;
            if (r < I_GU) { p0_transpose_item8(w_up + (size_t)e * 1024 * 512, 1024, 512, Wgu8 + (size_t)e * 1024 * 1024, 2, norm_ffn, SW8, scr, r, lane); continue; } r -= I_GU;
            p0_transpose_item8(w_down + (size_t)e * 512 * 1024, 512, 1024, Wd8 + (size_t)e * 1024 * 512, 0, nullptr, SD8, scr, r, lane);
        }
        for (int mrow = gw; mrow < NTOK; mrow += 4 * NGW) rms_rows_to_bf16<4>(x, norm_mix, hn, mrow, NGW, NTOK, lane, invrx);
        for (int mrow = gw; mrow < NMEMROW; mrow += 4 * NGW) rms_rows_to_fp8<4>(mem, norm_mem_kv, memn8, mrow, NGW, NMEMROW, lane);
        for (int i = gw * 64 + lane; i < (256 - 36) * 1024 / 8; i += NGW * 64) ((u32x4*)(WrT + 36 * 1024))[i] = (u32x4){0u, 0u, 0u, 0u};
    }
    SEAM(0);
    if (IN(1)) {
        { pg8::DenseOrder S; S.init(hn, WinT, NTOK, PROJW, DM, G, bx); pg8::EpiProj E{proj, kms};
          pg8::gemm_phase<pg8::EpiProj, pg8::DenseOrder, true, false, false>(lds, DM, S, E); }
        { pg8::DenseOrder S; S.init(memn8, Wkv8, NMEMROW, 2048, DM, G, bx, 1, true); pg8::EpiPlain E{kvmem, 2048, 1.0f / SW8};
          pg8::gemm_phase<pg8::EpiPlain, pg8::DenseOrder, true, true, false, true>(lds, DM, S, E); }
    }
    SEAM(1);
    if (IN(2)) {
        float lam;
        { const int ln = (int)__builtin_amdgcn_mbcnt_hi(~0u, __builtin_amdgcn_mbcnt_lo(~0u, 0u));
          const float a = wave_sum(lq1[ln] * lk1[ln]), c = wave_sum(lq2[ln] * lk2[ln]); lam = __expf(a) - __expf(c) + 0.2f; }
        for (int v = vcu; v < 256; v += G) { const int bh = v >> 1, b = bh >> 2, h = bh & 3, par = v & 1;
#pragma unroll 1
            for (int i = 0; i < 8; ++i) { const int s = 2 * (i >> 1) + par; const int qt = (i & 1) ? 15 - s : s; att::diff_unit(proj, mixed, diff_subln, lam, b, h, qt, (LAS char*)lds, wsf_all); } }
        for (int v = vcu; v < 256; v += G) { const int b = v >> 3, h = v & 7;
            LAS float* ksl = (LAS float*)(lds + MISC_OFF + 6144);
            { const size_t ko = ((size_t)(b * 8 + (tid >> 6))) * 512 + h * 64 + (tid & 63); ksl[tid] = kms[ko] + kms[ko + (size_t)256 * 512]; }
            __syncthreads();
#pragma unroll 1
            for (int own = 7; own >= 0; --own) att::moba_unit(proj, ksl, mixed, ssqA, b, h, own, (LAS char*)lds, wsf_all); }
    }
    SEAM(2);
    if (IN(3)) {
        pg8::DenseOrder S; S.init(mixed, WoutT, NTOK, DM, DM, G, bx); pg8::EpiOut E{hn, invrx, norm_mix, ssqA, h1, ssq1, h1f8, lds + MISC_OFF + 16384};
        pg8::gemm_phase<pg8::EpiOut, pg8::DenseOrder, true, false, true>(lds, DM, S, E);
    }
    SEAM(3);
    if (IN(4)) {
        pg8::DenseOrder S; S.init(h1f8, Wq8, NTOK, DM, DM, G, bx, 1, true); pg8::EpiQ E{ssq1, qmem, lds + MISC_OFF};
        pg8::gemm_phase<pg8::EpiQ, pg8::DenseOrder, true, true, false, true>(lds, DM, S, E);
    }
    SEAM(4);
    if (IN(5)) {
        for (int u = vcu; u < 1024; u += G) { const int qt = u & 7, mh = (u >> 3) & 3, b = u >> 5; att::cross_unit(qmem, kvmem, omem8, b, mh, qt, (LAS char*)lds, wsf_all); }
    }
    SEAM(5);
    if (IN(6)) {
        pg8::DenseOrder S; S.init(omem8, Wo8, NTOK, DM, DM, G, bx, 1, true); pg8::EpiRes E{h1, h2, ssq2, h2f8, 1.0f / (SH8 * SW8)};
        pg8::gemm_phase<pg8::EpiRes, pg8::DenseOrder, true, true, false, true>(lds, DM, S, E);
    }
    SEAM(6);
    if (IN(7)) {
        pg8::DenseOrder S; S.init(h2, WrT, NTOK, 256, DM, G, bx); pg8::EpiRouter E{ssq2, b_rg, b_re, ecnt, rowtok, roww, rowrstd};
        pg8::gemm_phase<pg8::EpiRouter, pg8::DenseOrder, false, false, false>(lds, DM, S, E);
    }
    SEAM(7);
    if (IN(8) || IN(9)) {
        if (tid == 0) { int ub = 0, hb = 0;
            for (int e = 0; e < 32; ++e) { const int c = (int)__hip_atomic_load(ecnt + e, RLX_AGENT); const int nrt = (c + 255) >> 8; mtab[e] = c; mtab[32 + e] = ub; mtab[65 + e] = hb; ub += nrt * 4; hb += nrt * 256; }
            mtab[64] = ub; mtab[97] = hb; }
        __syncthreads();
        if (tid < 16) { const int L = tid * G + bx; int e = -1, rt = 0, pn = 0, cn = 0, r0 = 0;
            if (L < mtab[64]) { e = 0; for (int k = 1; k < 32; ++k) if (L >= mtab[32 + k]) e = k;
                const int within = L - mtab[32 + e]; rt = within >> 2; pn = within & 3; cn = min(256, mtab[e] - rt * 256); r0 = mtab[65 + e] + rt * 256; }
            mtab[128 + 8 * tid] = e; mtab[128 + 8 * tid + 1] = rt; mtab[128 + 8 * tid + 2] = pn; mtab[128 + 8 * tid + 3] = cn; mtab[128 + 8 * tid + 4] = r0; }
        __syncthreads();
    }
    if (IN(8)) {
        pg8::MoeOrder S{mtab, (const char*)h2f8, (const char*)Wgu8, rowtok, DM, G, bx, true, 1}; pg8::EpiUp E{roww, rowrstd, Hid8, lds + MISC_OFF + 16384};
        pg8::gemm_phase<pg8::EpiUp, pg8::MoeOrder, true, true, false, true>(lds, DM, S, E);
    }
    SEAM(8);
    if (IN(9)) {
        pg8::MoeOrder S{mtab, (const char*)Hid8, (const char*)Wd8, rowtok, EFF, G, bx, false, 1}; pg8::EpiDown E{rowtok, y0, y1, lds + MISC_OFF + 16384};
        pg8::gemm_phase<pg8::EpiDown, pg8::MoeOrder, true, true, false, true>(lds, EFF, S, E);
    }
    SEAM(9);
    if (IN(10)) {
        const bool dead = xb_ld(&bar.bar[XB_TMO]) != 0u;
        const int ln = (int)__builtin_amdgcn_mbcnt_hi(~0u, __builtin_amdgcn_mbcnt_lo(~0u, 0u));
        const int gw = vcu * NWAVES + wave, NGW = G * NWAVES;
        for (int row = gw; row < NTOK; row += NGW) {
            const size_t off = (size_t)row * DM + 8 * ln;
            f32x4 v[4]; float s = 0.f;
#pragma unroll
            for (int j = 0; j < 2; ++j) { const u32x4 a = *(const u32x4*)(h2 + off + 512 * j); const u32x2 b = *(const u32x2*)(y0 + off + 512 * j), c = *(const u32x2*)(y1 + off + 512 * j);
                const f32x2 b0 = __builtin_amdgcn_cvt_pk_f32_fp8((int)b.x, false), b1 = __builtin_amdgcn_cvt_pk_f32_fp8((int)b.x, true), b2 = __builtin_amdgcn_cvt_pk_f32_fp8((int)b.y, false), b3 = __builtin_amdgcn_cvt_pk_f32_fp8((int)b.y, true);
                const f32x2 c0 = __builtin_amdgcn_cvt_pk_f32_fp8((int)c.x, false), c1 = __builtin_amdgcn_cvt_pk_f32_fp8((int)c.x, true), c2 = __builtin_amdgcn_cvt_pk_f32_fp8((int)c.y, false), c3 = __builtin_amdgcn_cvt_pk_f32_fp8((int)c.y, true);
                const float ys = 1.0f / SH8;
                v[2 * j] = (f32x4){bf_lo(a.x) + (b0[0] + c0[0]) * ys, bf_hi(a.x) + (b0[1] + c0[1]) * ys, bf_lo(a.y) + (b1[0] + c1[0]) * ys, bf_hi(a.y) + (b1[1] + c1[1]) * ys};
                v[2 * j + 1] = (f32x4){bf_lo(a.z) + (b2[0] + c2[0]) * ys, bf_hi(a.z) + (b2[1] + c2[1]) * ys, bf_lo(a.w) + (b3[0] + c3[0]) * ys, bf_hi(a.w) + (b3[1] + c3[1]) * ys}; }
#pragma unroll
            for (int j = 0; j < 4; ++j) s += (v[j][0] * v[j][0] + v[j][1] * v[j][1]) + (v[j][2] * v[j][2] + v[j][3] * v[j][3]);
            float rstd = 1.0f / sqrtf(wave_sum(s) * (1.0f / 1024.0f) + RMS_EPS);
            if (dead) rstd = __builtin_nanf("");
#pragma unroll
            for (int j = 0; j < 2; ++j) { const f32x4 g0 = *(const f32x4*)(norm_final + 8 * ln + 512 * j), g1 = *(const f32x4*)(norm_final + 8 * ln + 512 * j + 4);
                *(f32x4*)(args.out + off + 512 * j) = v[2 * j] * g0 * rstd; *(f32x4*)(args.out + off + 512 * j + 4) = v[2 * j + 1] * g1 * rstd; }
        }
    }
#undef IN
#undef SEAM
}

extern "C" void kernel_launch(void* const* d_in, const int* in_sizes, int n_in, void* d_out, int out_size, void* d_ws, size_t ws_size, hipStream_t stream) {
    static int grid = 0;
    if (grid == 0) {
        if (n_in != 25 || out_size != NTOK * DM || ws_size < WS_END) { fprintf(stderr, "kernel_launch: unexpected shapes (n_in %d out %d ws %zu)\n", n_in, out_size, ws_size); grid = -1; return; }
        int dev = 0, cus = 0, per_cu = 0;
        if (hipGetDevice(&dev) != hipSuccess || hipDeviceGetAttribute(&cus, hipDeviceAttributeMultiprocessorCount, dev) != hipSuccess) { grid = -1; return; }
        if (hipFuncSetAttribute((const void*)hymba_fwd, hipFuncAttributeMaxDynamicSharedMemorySize, LDS_BYTES) != hipSuccess) { fprintf(stderr, "kernel_launch: hipFuncSetAttribute failed\n"); grid = -1; return; }
        if (hipOccupancyMaxActiveBlocksPerMultiprocessor(&per_cu, (const void*)hymba_fwd, NWAVES * 64, LDS_BYTES) != hipSuccess || per_cu < 1) fprintf(stderr, "kernel_launch: occupancy query reports %d\n", per_cu);
        (void)hipGetLastError();
        grid = cus;
        if (grid != 256) { fprintf(stderr, "kernel_launch: expected 256 CUs, got %d\n", cus); if (grid > 256) grid = 256; }
    }
    if (grid < 0) return;
    if (hipMemsetAsync((char*)d_ws + WS_CTL, 0, CTL_ZERO_BYTES, stream) != hipSuccess) return;
    Args a{};
    for (int i = 0; i < 25; ++i) a.in[i] = (const float*)d_in[i];
    a.out = (float*)d_out; a.ws = (unsigned char*)d_ws;
    a.ph_lo = 0; a.ph_hi = NPHASE;
    hipLaunchKernelGGL(hymba_fwd, dim3(grid), dim3(NWAVES * 64), LDS_BYTES, stream, a);
}
```

```cpp
#include <hip/hip_runtime.h>
#include <cstdio>
#include <cstdint>

#define LAS __attribute__((address_space(3)))
#define GAS __attribute__((address_space(1)))
typedef unsigned short bf16_t;
typedef short bf16x8 __attribute__((ext_vector_type(8)));
typedef short s16x4 __attribute__((ext_vector_type(4)));
typedef float f32x4 __attribute__((ext_vector_type(4)));
typedef float f32x2 __attribute__((ext_vector_type(2)));
typedef float f32x16 __attribute__((ext_vector_type(16)));
typedef unsigned u32x4 __attribute__((ext_vector_type(4)));
typedef unsigned u32x2 __attribute__((ext_vector_type(2)));
typedef int i32x4 __attribute__((ext_vector_type(4)));
typedef int i32x8 __attribute__((ext_vector_type(8)));

constexpr int NTOK = 65536, DM = 1024, SEQ = 2048, NBATCH = 32, PROJW = 3072, MEMLEN = 256, NMEMROW = NBATCH * MEMLEN;
constexpr int NEXP = 32, EFF = 512;
constexpr float RMS_EPS = 1e-6f, LOG2E = 1.4426950408889634f;
constexpr float C2_64 = 0.125f * LOG2E;
constexpr float C2_256 = 0.0625f * LOG2E;
constexpr int HROWS = 131072 + NEXP * 256;

constexpr size_t MiB = 1u << 20;
constexpr size_t WS_CTL = 0, CTL_ZERO_BYTES = 1 * MiB;
constexpr size_t WS_WIN = 2 * MiB, WS_WOUT = 8 * MiB, WS_WQ = 10 * MiB, WS_WKV = 12 * MiB, WS_WO = 16 * MiB, WS_WR = 18 * MiB;
constexpr size_t WS_WGU = 20 * MiB, WS_WD = 84 * MiB, WS_MEMN = 116 * MiB, WS_KVMEM = 132 * MiB;
constexpr size_t WS_KMS = 164 * MiB, WS_SSQA = 166 * MiB, WS_SSQ1 = 168 * MiB, WS_SSQ2 = 172 * MiB;
constexpr size_t WS_INVRX = 176 * MiB;
constexpr size_t WS_ROWTOK = 180 * MiB, WS_ROWW = 188 * MiB, WS_ROWRSTD = 196 * MiB;
constexpr size_t WS_R0 = 204 * MiB;
constexpr size_t WS_H1 = 332 * MiB;
constexpr size_t WS_H2 = 460 * MiB;
constexpr size_t WS_BIG = 588 * MiB;
constexpr size_t WS_QMEM = WS_BIG, WS_OMEM = WS_BIG + 128 * MiB, WS_HID = WS_BIG;
constexpr size_t WS_END = 972 * MiB;
constexpr int CW_BAR = 4096;
constexpr int CW_ECNT = 16384;

constexpr int RING_BYTES = 131072;
constexpr int MISC_OFF = RING_BYTES;
constexpr int LDS_BYTES = 163840;

__device__ __forceinline__ unsigned cvt_pk_bf16(float lo, float hi) { unsigned r; asm volatile("v_cvt_pk_bf16_f32 %0, %1, %2" : "=v"(r) : "v"(lo), "v"(hi)); return r; }
__device__ __forceinline__ unsigned pk4_fp8(float a, float b, float c, float d) {
    a = __builtin_amdgcn_fmed3f(a, -448.f, 448.f); b = __builtin_amdgcn_fmed3f(b, -448.f, 448.f); c = __builtin_amdgcn_fmed3f(c, -448.f, 448.f); d = __builtin_amdgcn_fmed3f(d, -448.f, 448.f);
    int w = 0; w = __builtin_amdgcn_cvt_pk_fp8_f32(a, b, w, false); w = __builtin_amdgcn_cvt_pk_fp8_f32(c, d, w, true); return (unsigned)w; }
constexpr float SW8 = 32.f, SD8 = 16.f, SH8 = 16.f;
__device__ __forceinline__ float bf_lo(unsigned u) { return __uint_as_float(u << 16); }
__device__ __forceinline__ float bf_hi(unsigned u) { return __uint_as_float(u & 0xffff0000u); }
__device__ __forceinline__ float wave_sum(float v) {
#pragma unroll
    for (int o = 1; o < 64; o <<= 1) v += __shfl_xor(v, o);
    return v;
}
__device__ __forceinline__ float xhalf_max(float m) { auto rr = __builtin_amdgcn_permlane32_swap(__float_as_uint(m), __float_as_uint(m), false, false); return fmaxf(__uint_as_float(rr[0]), __uint_as_float(rr[1])); }
__device__ __forceinline__ float xhalf_sum(float m) { auto rr = __builtin_amdgcn_permlane32_swap(__float_as_uint(m), __float_as_uint(m), false, false); return __uint_as_float(rr[0]) + __uint_as_float(rr[1]); }
__device__ __forceinline__ int crow(int r, int hi) { return (r & 3) + 8 * (r >> 2) + 4 * hi; }
#define LDS_WAIT() asm volatile("s_waitcnt lgkmcnt(0)" ::: "memory")
#define VM_WAIT() asm volatile("s_waitcnt vmcnt(0)" ::: "memory")

namespace pg8 {
constexpr int BM = 256, BK = 64, HALF = 128, HTB = HALF * BK * 2, STAGE_BYTES = 8 * HTB, NXCD = 8, WGM = 8;
__host__ __device__ __forceinline__ int lds_byte(int r, int c) { const int st = (r >> 4) * 2 + (c >> 5), rr = r & 15, cc = c & 31, ob = rr * 64 + cc * 2; return st * 1024 + (ob ^ (((ob >> 9) & 1) << 5)); }
__host__ __device__ __forceinline__ void stage_rc(int b, int& R, int& C) { const int st = b / 1024, sb = b % 1024, swz = sb ^ (((sb >> 9) & 1) << 5); R = (st >> 1) * 16 + swz / 64; C = (st & 1) * 32 + (swz % 64) / 2; }
__host__ __device__ __forceinline__ int perm32(int rho) { const int n = rho >> 4, i = rho & 15; return 8 * (i >> 2) + 4 * n + (i & 3); }

struct Unit { int pm, pn; const char* a; const char* b; int e, cnt, row0, ui; };

struct DenseOrder {
    const char* A; const char* Bt; int K; int nM, nN, nwg, G, c; int esz; bool gat;
    __device__ void init(const void* A_, const void* Bt_, int M, int N, int K_, int G_, int c_, int esz_ = 2, bool gat_ = false) { A = (const char*)A_; Bt = (const char*)Bt_; K = K_; nM = M / BM; nN = N / BM; nwg = nM * nN; G = G_; c = c_; esz = esz_; gat = gat_; }
    __device__ bool next(int i, Unit& u) const {
        const long L = (long)i * G + c; if (L >= nwg) return false;
        int wgid = (int)L; { const int q = nwg / NXCD, r = nwg % NXCD, xcd = wgid % NXCD, off = wgid / NXCD; wgid = (xcd < r ? xcd * (q + 1) : r * (q + 1) + (xcd - r) * q) + off; }
        const int nig = WGM * nN, gid = wgid / nig, fm = gid * WGM, gsz = (nM - fm) < WGM ? (nM - fm) : WGM;
        u.pm = fm + ((wgid % nig) % gsz); u.pn = (wgid % nig) / gsz;
        u.a = gat ? A : A + (size_t)u.pm * BM * K * esz; u.b = Bt + (size_t)u.pn * BM * K * esz; u.e = 0; u.cnt = 256; u.row0 = u.pm * BM; u.ui = i; return true;
    }
    __device__ __forceinline__ int rowidx(const Unit& u, int r) const { return u.row0 + r; }
};

template <class Epi, class Sched, bool ALIGN_EPI, bool GATHER, bool MID, bool FP8 = false>
__device__ __forceinline__ void gemm_phase(LAS unsigned char* lds, const int K_, const Sched& S, const Epi& E) {
    int K = K_; if constexpr (FP8) asm volatile("" : "+s"(K));
    const int tid = threadIdx.x, wid = __builtin_amdgcn_readfirstlane(tid >> 6), lane = tid & 63, wr = wid >> 2, wc = wid & 3, fr = lane & 15, fq = lane >> 4;
    const int nt = FP8 ? K / 128 : K / BK;
    constexpr int ESZ = FP8 ? 1 : 2;
    unsigned voffB[2];
#pragma unroll
    for (int i = 0; i < 2; ++i) { int R, C; stage_rc(tid * 16 + i * 8192, R, C); const int Rb = Epi::PERM ? ((R & ~31) + perm32(R & 31)) : R; voffB[i] = FP8 ? (unsigned)(Rb * K + C * 2) : (unsigned)(Rb * K + C) * 2u; }
    const size_t kstep = (size_t)(BK * 2);
    const size_t hstep = (size_t)HALF * K * ESZ;
    const unsigned ldsw = (unsigned)wid * 1024u;
    const int aoff0 = lds_byte(wr * 64 + fr, fq * 8), aoff1 = aoff0 + 1024;
    const int boff0 = lds_byte(wc * 32 + fr, fq * 8), boff1 = boff0 + 1024;
#define PG8_SA(b, h) (((b) * 2 + (h)) * HTB)
#define PG8_SB(b, h) ((4 + (b) * 2 + (h)) * HTB)
#define PG8_STAGE(bufoff, gbase, voff) do { _Pragma("unroll") for (int _i = 0; _i < 2; ++_i) \
        __builtin_amdgcn_global_load_lds((const unsigned*)((const char*)(gbase) + (voff)[_i]), (LAS unsigned*)(lds + (bufoff) + ldsw + _i * 8192), 16, 0, 0); } while (0)
#define PG8_LD8(p) ({ const i32x4 lo_ = *(const LAS i32x4*)(p), hi_ = *(const LAS i32x4*)((p) + 0); (void)hi_; lo_; })
#define PG8_LDA(dst, b, h) do { if constexpr (FP8) { _Pragma("unroll") for (int m = 0; m < 4; ++m) { const i32x4 lo_ = *(const LAS i32x4*)(lds + PG8_SA(b, h) + aoff0 + m * 2048), hi_ = *(const LAS i32x4*)(lds + PG8_SA(b, h) + aoff1 + m * 2048); \
            dst##8[m] = (i32x8){lo_[0], lo_[1], lo_[2], lo_[3], hi_[0], hi_[1], hi_[2], hi_[3]}; } } \
        else { _Pragma("unroll") for (int m = 0; m < 4; ++m) _Pragma("unroll") for (int k = 0; k < 2; ++k) dst[m][k] = *(const LAS bf16x8*)(lds + PG8_SA(b, h) + (k ? aoff1 : aoff0) + m * 2048); } } while (0)
#define PG8_LDB(dst, b, h) do { if constexpr (FP8) { _Pragma("unroll") for (int n = 0; n < 2; ++n) { const i32x4 lo_ = *(const LAS i32x4*)(lds + PG8_SB(b, h) + boff0 + n * 2048), hi_ = *(const LAS i32x4*)(lds + PG8_SB(b, h) + boff1 + n * 2048); \
            dst##8[n] = (i32x8){lo_[0], lo_[1], lo_[2], lo_[3], hi_[0], hi_[1], hi_[2], hi_[3]}; } } \
        else { _Pragma("unroll") for (int n = 0; n < 2; ++n) _Pragma("unroll") for (int k = 0; k < 2; ++k) dst[n][k] = *(const LAS bf16x8*)(lds + PG8_SB(b, h) + (k ? boff1 : boff0) + n * 2048); } } while (0)
#define PG8_MMA(ai, bj, At, Bt) do { __builtin_amdgcn_s_setprio(1); _Pragma("unroll") for (int m = 0; m < 4; ++m) _Pragma("unroll") for (int n = 0; n < 2; ++n) { \
        if constexpr (FP8) acc[ai][bj][m][n] = __builtin_amdgcn_mfma_scale_f32_16x16x128_f8f6f4(Bt##8[n], At##8[m], acc[ai][bj][m][n], 0, 0, 0, 0x7f7f7f7f, 0, 0x7f7f7f7f); \
        else { _Pragma("unroll") for (int k = 0; k < 2; ++k) acc[ai][bj][m][n] = __builtin_amdgcn_mfma_f32_16x16x32_bf16(Bt[n][k], At[m][k], acc[ai][bj][m][n], 0, 0, 0); } } \
        __builtin_amdgcn_s_setprio(0); } while (0)
#define PG8_WAIT_V(n) asm volatile("s_waitcnt vmcnt(" #n ")" ::: "memory")
#define PG8_WAIT_L(n) asm volatile("s_waitcnt lgkmcnt(" #n ")" ::: "memory")
#define PG8_BAR __builtin_amdgcn_s_barrier()
#define PG8_SCHED __builtin_amdgcn_sched_barrier(0)
#define PG8_MKVO(u, vo) do { _Pragma("unroll") for (int _h = 0; _h < 2; ++_h) _Pragma("unroll") for (int _i = 0; _i < 2; ++_i) { int _R, _C; stage_rc(tid * 16 + _i * 8192, _R, _C); const int _r = _h * HALF + _R; \
        const int _src = GATHER ? S.rowidx(u, _r) : _r; vo[_h][_i] = FP8 ? (unsigned)(_src * K + _C * 2) : (unsigned)(_src * K + _C) * 2u; } } while (0)
    Unit cur, nxt; int ui = 0;
    if (!S.next(0, cur)) return;
    f32x4 acc[2][2][4][2];
#pragma unroll
    for (int a = 0; a < 2; ++a)
#pragma unroll
        for (int b = 0; b < 2; ++b)
#pragma unroll
            for (int m = 0; m < 4; ++m)
#pragma unroll
                for (int n = 0; n < 2; ++n) acc[a][b][m][n] = (f32x4){0.f, 0.f, 0.f, 0.f};
    bf16x8 At[4][2], B0[2][2], B1[2][2];
    i32x8 At8[4], B08[2], B18[2];
    unsigned vo[2][2];
    LAS u32x4* nvo_lds = (LAS u32x4*)(lds + STAGE_BYTES + 8192) + tid;
    PG8_MKVO(cur, vo);
    const char* cA = cur.a; const char* cB = cur.b;
    PG8_STAGE(PG8_SB(0, 0), cB, voffB); PG8_STAGE(PG8_SB(0, 1), cB + hstep, voffB); PG8_STAGE(PG8_SA(0, 0), cA, vo[0]); PG8_STAGE(PG8_SA(0, 1), cA, vo[1]);
    if (wr == 1) PG8_BAR;
    PG8_WAIT_V(2); PG8_BAR;
    PG8_STAGE(PG8_SB(1, 0), cB + kstep, voffB); PG8_STAGE(PG8_SA(1, 0), cA + kstep, vo[0]); PG8_STAGE(PG8_SB(1, 1), cB + hstep + kstep, voffB);
    PG8_WAIT_V(6); PG8_BAR;
    for (;;) {
        if constexpr (Epi::HOOK) E.begin(cur, lds + STAGE_BYTES);
        const bool has_next = S.next(ui + 1, nxt);
        const char* nA = has_next ? nxt.a : cA; const char* nB = has_next ? nxt.b : cB;
        if constexpr (GATHER) { unsigned nvo[2][2]; if (has_next) { PG8_MKVO(nxt, nvo); } else {
#pragma unroll
            for (int h = 0; h < 2; ++h)
#pragma unroll
                for (int i = 0; i < 2; ++i) nvo[h][i] = vo[h][i]; }
            *nvo_lds = (u32x4){nvo[0][0], nvo[0][1], nvo[1][0], nvo[1][1]}; }
#pragma unroll 1
        for (int t = 0; t < nt; t += 2) {
            const bool last = (t == nt - 2);
            if constexpr (MID) { if (t == (nt >> 1)) E.mid(acc, cur, wr, fr); }
            const char* a1 = cA + (size_t)(t + 1) * kstep;
            const char* a2 = last ? nA : cA + (size_t)(t + 2) * kstep; const char* b2 = last ? nB : cB + (size_t)(t + 2) * kstep;
            const char* a3 = a2 + kstep; const char* b3 = b2 + kstep;
            PG8_LDB(B0, 0, 0); PG8_LDB(B1, 0, 1); PG8_SCHED; PG8_LDA(At, 0, 0); PG8_STAGE(PG8_SA(1, 1), a1, vo[1]);
            if constexpr (GATHER) { if (last) { const u32x4 nv = *nvo_lds; vo[0][0] = nv.x; vo[0][1] = nv.y; vo[1][0] = nv.z; vo[1][1] = nv.w; } }
            PG8_WAIT_V(8); PG8_WAIT_L(0); PG8_BAR; PG8_MMA(0, 0, At, B0); PG8_MMA(0, 1, At, B1); PG8_BAR; PG8_SCHED;
            PG8_LDA(At, 0, 1); PG8_STAGE(PG8_SB(0, 0), b2, voffB); PG8_STAGE(PG8_SB(0, 1), b2 + hstep, voffB); PG8_STAGE(PG8_SA(0, 0), a2, vo[0]);
            PG8_WAIT_V(8); PG8_WAIT_L(0); PG8_BAR; PG8_MMA(1, 0, At, B0); PG8_MMA(1, 1, At, B1); PG8_BAR; PG8_SCHED;
            PG8_LDB(B0, 1, 0); PG8_LDB(B1, 1, 1); PG8_SCHED; PG8_LDA(At, 1, 0); PG8_STAGE(PG8_SA(0, 1), a2, vo[1]);
            PG8_WAIT_V(8); PG8_WAIT_L(0); PG8_BAR; PG8_MMA(0, 0, At, B0); PG8_MMA(0, 1, At, B1); PG8_BAR; PG8_SCHED;
            PG8_LDA(At, 1, 1); PG8_STAGE(PG8_SB(1, 0), b3, voffB); PG8_STAGE(PG8_SB(1, 1), b3 + hstep, voffB); PG8_STAGE(PG8_SA(1, 0), a3, vo[0]);
            PG8_WAIT_V(8); PG8_WAIT_L(0); PG8_BAR; PG8_MMA(1, 0, At, B0); PG8_MMA(1, 1, At, B1); PG8_BAR; PG8_SCHED;
        }
        if constexpr (ALIGN_EPI) { if (wr == 0) PG8_BAR; }
        if constexpr (!Epi::AFTER_DRAIN) { E(acc, cur, wr, wc, fr, fq); }
        if (!has_next) break;
#pragma unroll
        for (int a = 0; a < 2; ++a)
#pragma unroll
            for (int b = 0; b < 2; ++b)
#pragma unroll
                for (int m = 0; m < 4; ++m)
#pragma unroll
                    for (int n = 0; n < 2; ++n) acc[a][b][m][n] = (f32x4){0.f, 0.f, 0.f, 0.f};
        cur = nxt; cA = nA; cB = nB; ++ui;
        if constexpr (ALIGN_EPI) { if (wr == 1) PG8_BAR; }
    }
    PG8_WAIT_V(0);
    if constexpr (!ALIGN_EPI) { if (wr == 0) PG8_BAR; }
    PG8_BAR;
    if constexpr (Epi::AFTER_DRAIN) { E.fused(acc, cur, wr, wc, fr, fq, lds, wid, lane); }
#undef PG8_SA
#undef PG8_SB
#undef PG8_STAGE
#undef PG8_LDA
#undef PG8_LDB
#undef PG8_MMA
#undef PG8_WAIT_V
#undef PG8_WAIT_L
#undef PG8_BAR
#undef PG8_SCHED
#undef PG8_MKVO
#undef PG8_LD8
}

#define ACC_T const f32x4 (&acc)[2][2][4][2]
__device__ __forceinline__ u32x4 pack8(f32x4 v0, f32x4 v1) { u32x4 w; w.x = cvt_pk_bf16(v0[0], v0[1]); w.y = cvt_pk_bf16(v0[2], v0[3]); w.z = cvt_pk_bf16(v1[0], v1[1]); w.w = cvt_pk_bf16(v1[2], v1[3]); return w; }

constexpr size_t PREG = (size_t)NTOK * 512;
__device__ __forceinline__ size_t proj_off(int c, int& rstride) {
    if (c < 1536) { rstride = 64; return (size_t)(c >> 9) * PREG + (size_t)((c & 511) >> 6) * (SEQ * 64) + (c & 63); }
    if (c < 2560) { const int cc = c - 1536; rstride = 64; return (size_t)(3 + (cc >> 9)) * PREG + (size_t)((cc & 511) >> 6) * (SEQ * 64) + (cc & 63); }
    const int cc = c - 2560; rstride = 128; return 5 * PREG + (size_t)(cc >> 7) * (SEQ * 128) + (cc & 127);
}
struct EpiProj {
    static constexpr bool PERM = true, AFTER_DRAIN = false, HOOK = false;
    bf16_t* O; float* kms;
    __device__ __forceinline__ void operator()(ACC_T, const Unit& u, int wr, int wc, int fr, int fq) const {
        const int pn = u.pn; const float sc = (pn < 2 || (pn >= 6 && pn < 8)) ? C2_64 : 1.f;
        const int bq = u.pm >> 3, s0 = (u.pm & 7) * 256 + wr * 64 + fr;
        bf16_t* ob[2]; int rs[2];
#pragma unroll
        for (int bj = 0; bj < 2; ++bj) { const int c = pn * BM + bj * HALF + wc * 32 + 8 * fq; int st; const size_t off = proj_off(c, st); ob[bj] = O + off + ((size_t)bq << 20); rs[bj] = st; }
#pragma unroll
        for (int ai = 0; ai < 2; ++ai)
#pragma unroll
            for (int m = 0; m < 4; ++m) { const int srow = s0 + ai * HALF + m * 16;
#pragma unroll
                for (int bj = 0; bj < 2; ++bj) *(u32x4*)(ob[bj] + (size_t)srow * rs[bj]) = pack8(acc[ai][bj][m][0] * sc, acc[ai][bj][m][1] * sc); }
        if (pn == 2 || pn == 3) {
            f32x4 cs[2][2];
#pragma unroll
            for (int bj = 0; bj < 2; ++bj)
#pragma unroll
                for (int n = 0; n < 2; ++n) { f32x4 s = (f32x4){0.f, 0.f, 0.f, 0.f};
#pragma unroll
                    for (int ai = 0; ai < 2; ++ai)
#pragma unroll
                        for (int m = 0; m < 4; ++m) s += acc[ai][bj][m][n];
#pragma unroll
                    for (int o = 1; o < 16; o <<= 1) { s[0] += __shfl_xor(s[0], o); s[1] += __shfl_xor(s[1], o); s[2] += __shfl_xor(s[2], o); s[3] += __shfl_xor(s[3], o); }
                    cs[bj][n] = s; }
            if (fr == 0) { float* kp = kms + ((size_t)wr * 256 + u.pm) * 512 + (pn - 2) * 256 + wc * 32 + 8 * fq;
#pragma unroll
                for (int bj = 0; bj < 2; ++bj) { *(f32x4*)(kp + bj * HALF) = cs[bj][0]; *(f32x4*)(kp + bj * HALF + 4) = cs[bj][1]; } }
        }
    }
};
struct EpiPlain {
    static constexpr bool PERM = true, AFTER_DRAIN = false, HOOK = false;
    bf16_t* O; int ldc; float sc;
    __device__ __forceinline__ void operator()(ACC_T, const Unit& u, int wr, int wc, int fr, int fq) const {
        const int row0 = u.pm * BM + wr * 64 + fr, col0 = u.pn * BM + wc * 32 + 8 * fq;
#pragma unroll
        for (int ai = 0; ai < 2; ++ai)
#pragma unroll
            for (int m = 0; m < 4; ++m) { bf16_t* rowp = O + (size_t)(row0 + ai * HALF + m * 16) * ldc + col0;
#pragma unroll
                for (int bj = 0; bj < 2; ++bj) *(u32x4*)(rowp + bj * HALF) = pack8(acc[ai][bj][m][0] * sc, acc[ai][bj][m][1] * sc); }
    }
};
__device__ __forceinline__ void ssq_partial(float q, float* ssq, int row, int slot, int fq) {
    q += __shfl_xor(q, 16); q += __shfl_xor(q, 32);
    if (fq == 0) ssq[(size_t)row * 16 + slot] = q;
}
struct EpiOut {
    static constexpr bool PERM = true, AFTER_DRAIN = false, HOOK = true;
    const bf16_t* hn; const float* invrx; const float* gmix; const float* ssqA; bf16_t* h1; float* ssq1; unsigned char* h1f8; LAS unsigned char* meta;
    __device__ __forceinline__ void begin(const Unit& u, LAS unsigned char*) const {
        if (threadIdx.x < 256) { const int row = u.pm * BM + threadIdx.x;
            const f32x4 a = *(const f32x4*)(ssqA + (size_t)row * 8), b = *(const f32x4*)(ssqA + (size_t)row * 8 + 4);
            const float s = ((a[0] + a[1]) + (a[2] + a[3])) + ((b[0] + b[1]) + (b[2] + b[3]));
            ((LAS f32x2*)(meta + (u.ui & 1) * 2048))[threadIdx.x] = (f32x2){1.0f / sqrtf(s * (1.0f / 512.0f) + RMS_EPS), invrx[row]}; }
    }
    __device__ __forceinline__ void mid(f32x4 (&acc)[2][2][4][2], const Unit& u, int wr, int fr) const {
        const LAS f32x2* mt = (const LAS f32x2*)(meta + (u.ui & 1) * 2048);
#pragma unroll
        for (int ai = 0; ai < 2; ++ai)
#pragma unroll
            for (int m = 0; m < 4; ++m) { const float r = mt[ai * HALF + wr * 64 + m * 16 + fr][0];
#pragma unroll
                for (int bj = 0; bj < 2; ++bj)
#pragma unroll
                    for (int n = 0; n < 2; ++n) acc[ai][bj][m][n] *= r; }
    }
    __device__ __forceinline__ void operator()(ACC_T, const Unit& u, int wr, int wc, int fr, int fq) const {
        const LAS f32x2* mt = (const LAS f32x2*)(meta + (u.ui & 1) * 2048);
        const int row0 = u.pm * BM + wr * 64 + fr, col0 = u.pn * BM + wc * 32 + 8 * fq;
        f32x4 ig[2][2];
#pragma unroll
        for (int bj = 0; bj < 2; ++bj)
#pragma unroll
            for (int n = 0; n < 2; ++n) { const f32x4 g = *(const f32x4*)(gmix + col0 + bj * HALF + 4 * n);
                ig[bj][n] = (f32x4){__builtin_amdgcn_rcpf(g[0]), __builtin_amdgcn_rcpf(g[1]), __builtin_amdgcn_rcpf(g[2]), __builtin_amdgcn_rcpf(g[3])}; }
#pragma unroll
        for (int ai = 0; ai < 2; ++ai) {
            u32x4 hv[4][2];
#pragma unroll
            for (int m = 0; m < 4; ++m) { const size_t off = (size_t)(row0 + ai * HALF + m * 16) * DM + col0;
#pragma unroll
                for (int bj = 0; bj < 2; ++bj) hv[m][bj] = *(const u32x4*)(hn + off + bj * HALF); }
#pragma unroll
            for (int m = 0; m < 4; ++m) { const int row = row0 + ai * HALF + m * 16; const size_t off = (size_t)row * DM + col0; float q = 0.f;
                const float ir = mt[ai * HALF + wr * 64 + m * 16 + fr][1];
#pragma unroll
                for (int bj = 0; bj < 2; ++bj) { const u32x4 hb = hv[m][bj];
                    const f32x4 v0 = acc[ai][bj][m][0] + (f32x4){bf_lo(hb.x), bf_hi(hb.x), bf_lo(hb.y), bf_hi(hb.y)} * ig[bj][0] * ir, v1 = acc[ai][bj][m][1] + (f32x4){bf_lo(hb.z), bf_hi(hb.z), bf_lo(hb.w), bf_hi(hb.w)} * ig[bj][1] * ir;
                    q += (v0[0] * v0[0] + v0[1] * v0[1]) + (v0[2] * v0[2] + v0[3] * v0[3]) + (v1[0] * v1[0] + v1[1] * v1[1]) + (v1[2] * v1[2] + v1[3] * v1[3]);
                    *(u32x4*)(h1 + off + bj * HALF) = pack8(v0, v1);
                    *(u32x2*)(h1f8 + off + bj * HALF) = (u32x2){pk4_fp8(v0[0], v0[1], v0[2], v0[3]), pk4_fp8(v1[0], v1[1], v1[2], v1[3])}; }
                ssq_partial(q, ssq1, row, u.pn * 4 + wc, fq); }
            asm volatile("" ::: "memory"); }
    }
};
__device__ __forceinline__ float rstd_from16(const float* ssq, int row) {
    const f32x4 a = *(const f32x4*)(ssq + (size_t)row * 16), b = *(const f32x4*)(ssq + (size_t)row * 16 + 4), c = *(const f32x4*)(ssq + (size_t)row * 16 + 8), d = *(const f32x4*)(ssq + (size_t)row * 16 + 12);
    const float s = (((a[0] + a[1]) + (a[2] + a[3])) + ((b[0] + b[1]) + (b[2] + b[3]))) + (((c[0] + c[1]) + (c[2] + c[3])) + ((d[0] + d[1]) + (d[2] + d[3])));
    return 1.0f / sqrtf(s * (1.0f / 1024.0f) + RMS_EPS);
}
struct EpiQ {
    static constexpr bool PERM = true, AFTER_DRAIN = false, HOOK = true;
    const float* ssq1; bf16_t* O; LAS unsigned char* misc;
    __device__ __forceinline__ void begin(const Unit& u, LAS unsigned char*) const {
        if (threadIdx.x < 256) ((LAS float*)(misc + ((u.ui & 1) ? 5120 : 3072)))[threadIdx.x] = rstd_from16(ssq1, u.pm * BM + threadIdx.x) * (C2_256 / SW8);
    }
    __device__ __forceinline__ void operator()(ACC_T, const Unit& u, int wr, int wc, int fr, int fq) const {
        const int row0 = u.pm * BM + wr * 64 + fr, col0 = u.pn * BM + wc * 32 + 8 * fq;
        const LAS float* tab = (const LAS float*)(misc + ((u.ui & 1) ? 5120 : 3072));
#pragma unroll
        for (int ai = 0; ai < 2; ++ai)
#pragma unroll
            for (int m = 0; m < 4; ++m) { const float r = tab[ai * HALF + wr * 64 + m * 16 + fr]; bf16_t* rowp = O + (size_t)(row0 + ai * HALF + m * 16) * DM + col0;
#pragma unroll
                for (int bj = 0; bj < 2; ++bj) *(u32x4*)(rowp + bj * HALF) = pack8(acc[ai][bj][m][0] * r, acc[ai][bj][m][1] * r); }
    }
};
struct EpiRes {
    static constexpr bool PERM = true, AFTER_DRAIN = false, HOOK = false;
    const bf16_t* h1; bf16_t* h2; float* ssq2; unsigned char* h2f8; float asc;
    __device__ __forceinline__ void operator()(ACC_T, const Unit& u, int wr, int wc, int fr, int fq) const {
        const int row0 = u.pm * BM + wr * 64 + fr, col0 = u.pn * BM + wc * 32 + 8 * fq;
        u32x4 hv[2][4][2];
#pragma unroll
        for (int ai = 0; ai < 2; ++ai)
#pragma unroll
            for (int m = 0; m < 4; ++m) { const size_t off = (size_t)(row0 + ai * HALF + m * 16) * DM + col0;
#pragma unroll
                for (int bj = 0; bj < 2; ++bj) hv[ai][m][bj] = *(const u32x4*)(h1 + off + bj * HALF); }
#pragma unroll
        for (int ai = 0; ai < 2; ++ai)
#pragma unroll
            for (int m = 0; m < 4; ++m) { const int row = row0 + ai * HALF + m * 16; const size_t off = (size_t)row * DM + col0; float q = 0.f;
#pragma unroll
                for (int bj = 0; bj < 2; ++bj) { const u32x4 hb = hv[ai][m][bj];
                    const f32x4 v0 = acc[ai][bj][m][0] * asc + (f32x4){bf_lo(hb.x), bf_hi(hb.x), bf_lo(hb.y), bf_hi(hb.y)}, v1 = acc[ai][bj][m][1] * asc + (f32x4){bf_lo(hb.z), bf_hi(hb.z), bf_lo(hb.w), bf_hi(hb.w)};
                    q += (v0[0] * v0[0] + v0[1] * v0[1]) + (v0[2] * v0[2] + v0[3] * v0[3]) + (v1[0] * v1[0] + v1[1] * v1[1]) + (v1[2] * v1[2] + v1[3] * v1[3]);
                    *(u32x4*)(h2 + off + bj * HALF) = pack8(v0, v1);
                    *(u32x2*)(h2f8 + off + bj * HALF) = (u32x2){pk4_fp8(v0[0], v0[1], v0[2], v0[3]), pk4_fp8(v1[0], v1[1], v1[2], v1[3])}; }
                ssq_partial(q, ssq2, row, u.pn * 4 + wc, fq); }
    }
};
struct EpiRouter {
    static constexpr bool PERM = false, AFTER_DRAIN = true, HOOK = false;
    const float* ssq2; const float* b_rg; const float* b_re; unsigned* ecnt; int* rowtok; float* roww; float* rowrstd;
    __device__ __forceinline__ void operator()(ACC_T, const Unit&, int, int, int, int) const {}
    __device__ __forceinline__ void fused(f32x4 (&acc)[2][2][4][2], const Unit& u, int wr, int wc, int fr, int fq, LAS unsigned char* lds, int wid, int lane) const {
        LAS float* L = (LAS float*)lds;
        LAS int* lcnt = (LAS int*)(lds + 49152); LAS int* lbase = lcnt + 32;
        const int tid = threadIdx.x;
        if (tid < 32) lcnt[tid] = 0;
        if (wc == 0) {
#pragma unroll
            for (int ai = 0; ai < 2; ++ai)
#pragma unroll
                for (int m = 0; m < 4; ++m) { const int rl = ai * HALF + wr * 64 + m * 16 + fr;
                    *(LAS f32x4*)(L + rl * 40 + 4 * fq) = acc[ai][0][m][0]; *(LAS f32x4*)(L + rl * 40 + 16 + 4 * fq) = acc[ai][0][m][1]; }
        } else if (wc == 1 && fq == 0) {
#pragma unroll
            for (int ai = 0; ai < 2; ++ai)
#pragma unroll
                for (int m = 0; m < 4; ++m) { const int rl = ai * HALF + wr * 64 + m * 16 + fr; *(LAS f32x4*)(L + rl * 40 + 32) = acc[ai][0][m][0]; }
        }
        __syncthreads();
        int e0 = 0, e1 = 0, p0 = 0, p1 = 0; float cw0 = 0.f, cw1 = 0.f, rs = 0.f; const int row = u.pm * BM + tid;
        if (tid < 256) {
            rs = rstd_from16(ssq2, row);
            float gl[4];
#pragma unroll
            for (int g = 0; g < 4; ++g) gl[g] = L[tid * 40 + g] * rs + b_rg[g];
            int grp = 0; float gm = gl[0];
#pragma unroll
            for (int g = 1; g < 4; ++g) if (gl[g] > gm) { gm = gl[g]; grp = g; }
            float gs = 0.f;
#pragma unroll
            for (int g = 0; g < 4; ++g) gs += __expf(gl[g] - gm);
            const float gw = 1.0f / gs;
            float ev[8];
#pragma unroll
            for (int i = 0; i < 8; ++i) ev[i] = L[tid * 40 + 4 + grp * 8 + i] * rs + b_re[grp * 8 + i];
            int i0 = 0; float v0 = ev[0];
#pragma unroll
            for (int i = 1; i < 8; ++i) if (ev[i] > v0) { v0 = ev[i]; i0 = i; }
            int i1 = -1; float v1 = -3.0e38f;
#pragma unroll
            for (int i = 0; i < 8; ++i) if (i != i0 && ev[i] > v1) { v1 = ev[i]; i1 = i; }
            const float w0 = 1.0f / (1.0f + __expf(v1 - v0)), w1 = 1.0f - w0;
            e0 = grp * 8 + i0; e1 = grp * 8 + i1; cw0 = gw * w0; cw1 = gw * w1;
            p0 = __hip_atomic_fetch_add(&lcnt[e0], 1, __ATOMIC_RELAXED, __HIP_MEMORY_SCOPE_WORKGROUP); p1 = __hip_atomic_fetch_add(&lcnt[e1], 1, __ATOMIC_RELAXED, __HIP_MEMORY_SCOPE_WORKGROUP);
        }
        __syncthreads();
        if (tid < 32) lbase[tid] = (int)__hip_atomic_fetch_add(ecnt + tid, (unsigned)lcnt[tid], __ATOMIC_RELAXED, __HIP_MEMORY_SCOPE_AGENT);
        __syncthreads();
        if (tid < 256) {
            const int q0 = lbase[e0] + p0, q1 = lbase[e1] + p1;
            rowtok[(size_t)e0 * NTOK + q0] = row * 2; roww[(size_t)e0 * NTOK + q0] = cw0; rowrstd[(size_t)e0 * NTOK + q0] = rs;
            rowtok[(size_t)e1 * NTOK + q1] = row * 2 + 1; roww[(size_t)e1 * NTOK + q1] = cw1; rowrstd[(size_t)e1 * NTOK + q1] = rs;
        }
    }
};
struct MoeOrder {
    const LAS int* tab; const char* A; const char* Bt; const int* rowtok; int K, G, c; bool up; int esz;
    __device__ __forceinline__ bool next(int i, Unit& u) const {
        if (i >= 16) return false;
        const i32x4 t0 = *(const LAS i32x4*)(tab + 128 + 8 * i); const int r0 = tab[128 + 8 * i + 4];
        const int e = __builtin_amdgcn_readfirstlane(t0[0]); if (e < 0) return false;
        const int rt = __builtin_amdgcn_readfirstlane(t0[1]), pn = __builtin_amdgcn_readfirstlane(t0[2]);
        u.ui = i; u.e = e; u.pm = rt; u.pn = pn; u.cnt = __builtin_amdgcn_readfirstlane(t0[3]); u.row0 = __builtin_amdgcn_readfirstlane(r0);
        u.b = Bt + ((size_t)e * 1024 + (size_t)pn * 256) * K * esz;
        u.a = A;
        return true;
    }
    __device__ __forceinline__ int rowidx(const Unit& u, int r) const { return up ? (rowtok[(size_t)u.e * NTOK + u.pm * 256 + min(r, u.cnt - 1)] >> 1) : u.row0 + r; }
};
struct EpiUp {
    static constexpr bool PERM = true, AFTER_DRAIN = false, HOOK = true;
    const float* roww; const float* rowrstd; unsigned char* H; LAS unsigned char* meta;
    __device__ __forceinline__ void begin(const Unit& u, LAS unsigned char*) const {
        if (threadIdx.x < 256) { const size_t li = (size_t)u.e * NTOK + u.pm * 256 + min((int)threadIdx.x, u.cnt - 1);
            ((LAS f32x2*)(meta + (u.ui & 1) * 2048))[threadIdx.x] = (f32x2){rowrstd[li] * (1.0f / SW8), roww[li] * SH8}; }
    }
    __device__ __forceinline__ void operator()(ACC_T, const Unit& u, int wr, int wc, int fr, int fq) const {
        const LAS f32x2* mt = (const LAS f32x2*)(meta + (u.ui & 1) * 2048);
#pragma unroll
        for (int ai = 0; ai < 2; ++ai)
#pragma unroll
            for (int m = 0; m < 4; ++m) { const int rl = ai * HALF + wr * 64 + m * 16 + fr;
                if (rl < u.cnt) { const f32x2 mv = mt[rl]; const float rs = mv[0], w = mv[1];
                    f32x4 o[2];
#pragma unroll
                    for (int n = 0; n < 2; ++n)
#pragma unroll
                        for (int j = 0; j < 4; ++j) { const float g = acc[ai][0][m][n][j] * rs, up = acc[ai][1][m][n][j] * rs;
                            o[n][j] = g * __builtin_amdgcn_rcpf(1.0f + __builtin_amdgcn_exp2f(-g * LOG2E)) * up * w; }
                    *(u32x2*)(H + (size_t)(u.row0 + rl) * EFF + u.pn * 128 + wc * 32 + 8 * fq) = (u32x2){pk4_fp8(o[0][0], o[0][1], o[0][2], o[0][3]), pk4_fp8(o[1][0], o[1][1], o[1][2], o[1][3])}; } }
    }
};
struct EpiDown {
    static constexpr bool PERM = true, AFTER_DRAIN = false, HOOK = true;
    const int* rowtok; unsigned char* y0; unsigned char* y1; LAS unsigned char* meta;
    __device__ __forceinline__ void begin(const Unit& u, LAS unsigned char*) const {
        if (threadIdx.x < 256) ((LAS int*)(meta + (u.ui & 1) * 1024))[threadIdx.x] = rowtok[(size_t)u.e * NTOK + u.pm * 256 + min((int)threadIdx.x, u.cnt - 1)];
    }
    __device__ __forceinline__ void operator()(ACC_T, const Unit& u, int wr, int wc, int fr, int fq) const {
        const LAS int* mt = (const LAS int*)(meta + (u.ui & 1) * 1024);
        const float sc = 1.0f / SD8;
#pragma unroll
        for (int ai = 0; ai < 2; ++ai)
#pragma unroll
            for (int m = 0; m < 4; ++m) { const int rl = ai * HALF + wr * 64 + m * 16 + fr;
                if (rl < u.cnt) { const int tk = mt[rl]; unsigned char* rowp = ((tk & 1) ? y1 : y0) + (size_t)(tk >> 1) * DM + u.pn * BM + wc * 32 + 8 * fq;
#pragma unroll
                    for (int bj = 0; bj < 2; ++bj) { const f32x4 v0 = acc[ai][bj][m][0] * sc, v1 = acc[ai][bj][m][1] * sc;
                        *(u32x2*)(rowp + bj * HALF) = (u32x2){pk4_fp8(v0[0], v0[1], v0[2], v0[3]), pk4_fp8(v1[0], v1[1], v1[2], v1[3])}; } } }
    }
};
#undef ACC_T
}

namespace att {
typedef short v4i16_t __attribute__((ext_vector_type(4)));
__device__ __forceinline__ s16x4 vtr(const LAS char* p) { return __builtin_bit_cast(s16x4, __builtin_amdgcn_ds_read_tr16_b64_v4i16((LAS v4i16_t*)p)); }
__device__ __forceinline__ bf16x8 vfrag(const LAS char* p) { const s16x4 lo = vtr(p), hi = vtr(p + 512); return (bf16x8){lo[0], lo[1], lo[2], lo[3], hi[0], hi[1], hi[2], hi[3]}; }
__device__ __forceinline__ bf16x8 pfrag(const f32x16& p, int b) {
    u32x4 w; w.x = cvt_pk_bf16(p[b], p[b + 1]); w.y = cvt_pk_bf16(p[b + 2], p[b + 3]); w.z = cvt_pk_bf16(p[b + 4], p[b + 5]); w.w = cvt_pk_bf16(p[b + 6], p[b + 7]); return __builtin_bit_cast(bf16x8, w); }

__device__ __forceinline__ void glds16(const void* gsrc, unsigned lds_dst) { unsigned keep;
    asm volatile("s_mov_b32 %0, m0\n\ts_mov_b32 m0, %2\n\ts_nop 0\n\tglobal_load_lds_dwordx4 %1, off\n\ts_mov_b32 m0, %0" : "=&s"(keep) : "v"(gsrc), "s"(lds_dst) : "memory"); }
#define WAIT_BAR(N) asm volatile("s_waitcnt vmcnt(" #N ") lgkmcnt(0)\n\ts_barrier" ::: "memory")
#define MX3(a, b, c) __builtin_fmaxf(__builtin_fmaxf((a), (b)), (c))
__device__ __forceinline__ float fadd_s(float a, float b) { float r; asm("v_add_f32_e32 %0, %1, %2" : "=v"(r) : "v"(a), "v"(b)); return r; }
constexpr float THR = 8.0f, PZERO = -151.0f;

template <int NDB>
__device__ __forceinline__ void tile64(const LAS char* kbuf, const LAS char* vbuf, const int (&koff)[4], const bf16x8 (&qr)[4], float slope2, float u, float s32,
                                       bool causal, int kvrel0, int qrel, float& mref, float& l, f32x16 (&o)[NDB], LAS float* wsf, int r32, int hi, int lane) {
    bf16x8 kf[8];
#pragma unroll
    for (int s = 0; s < 4; ++s) { kf[2 * s] = *(const LAS bf16x8*)(kbuf + koff[s]); kf[2 * s + 1] = *(const LAS bf16x8*)(kbuf + koff[s] + 4096); }
    f32x16 p0, p1;
    { const float u0 = __builtin_fmaf(slope2, (float)(4 * hi), u), u1 = u0 + s32;
#pragma unroll
      for (int r = 0; r < 16; ++r) { const float cr = (float)((r & 3) + 8 * (r >> 2)); p0[r] = __builtin_fmaf(slope2, cr, u0); p1[r] = __builtin_fmaf(slope2, cr, u1); } }
    __builtin_amdgcn_sched_barrier(0);
#pragma unroll
    for (int s = 0; s < 4; ++s) {
        p0 = __builtin_amdgcn_mfma_f32_32x32x16_bf16(kf[2 * s], qr[s], p0, 0, 0, 0);
        p1 = __builtin_amdgcn_mfma_f32_32x32x16_bf16(kf[2 * s + 1], qr[s], p1, 0, 0, 0);
    }
    const LAS char* vp = vbuf + ((lane >> 4) & 1) * 32 + (lane & 3) * 8 + (4 * hi + ((lane & 15) >> 2)) * 64;
    bf16x8 vf[NDB][4];
#pragma unroll
    for (int ks = 0; ks < 4; ++ks) vf[0][ks] = vfrag(vp + ks * 1024);
    __builtin_amdgcn_sched_barrier(0);
    if (causal) {
#pragma unroll
        for (int r = 0; r < 16; ++r) { const int kv = kvrel0 + crow(r, hi); if (kv > qrel) p0[r] = -INFINITY; if (kv + 32 > qrel) p1[r] = -INFINITY; }
    }
    float ra = MX3(p0[0], p0[1], p1[0]), rb = MX3(p0[2], p0[3], p1[1]); ra = MX3(ra, p1[2], p1[3]);
#pragma unroll
    for (int r = 4; r < 16; r += 4) { ra = MX3(ra, p0[r], p0[r + 1]); rb = MX3(rb, p0[r + 2], p0[r + 3]); ra = MX3(ra, p1[r], p1[r + 1]); rb = MX3(rb, p1[r + 2], p1[r + 3]); }
    const float rm = xhalf_max(fmaxf(ra, rb));
    if (__all(rm < PZERO)) return;
    if (__any(rm > THR)) {
        const float dl = fmaxf(rm, 0.f); mref += dl;
#pragma unroll
        for (int r = 0; r < 16; ++r) { p0[r] -= dl; p1[r] -= dl; }
        const float f = __builtin_amdgcn_exp2f(-dl); l *= f;
        if (hi == 0) wsf[r32] = f;
        LDS_WAIT();
#pragma unroll
        for (int r = 0; r < 16; ++r) { const float fr_ = wsf[crow(r, hi)];
#pragma unroll
            for (int d = 0; d < NDB; ++d) o[d][r] *= fr_; }
    }
    {
    float sum = 0.f;
#pragma unroll
    for (int r = 0; r < 16; ++r) { p0[r] = __builtin_amdgcn_exp2f(p0[r]); p1[r] = __builtin_amdgcn_exp2f(p1[r]); }
    asm volatile("s_nop 1" : "+v"(p0), "+v"(p1));
    float sb = 0.f;
#pragma unroll
    for (int r = 0; r < 16; ++r) { sum = fadd_s(sum, p0[r]); sb = fadd_s(sb, p1[r]); }
    l += sum + sb; }
    const bf16x8 pa0 = pfrag(p0, 0), pa1 = pfrag(p0, 8), pa2 = pfrag(p1, 0), pa3 = pfrag(p1, 8);
    __builtin_amdgcn_sched_barrier(0);
#pragma unroll
    for (int d = 0; d < NDB; ++d) {
        if (d + 1 < NDB) {
#pragma unroll
            for (int ks = 0; ks < 4; ++ks) vf[d + 1][ks] = vfrag(vp + (d + 1) * 4096 + ks * 1024);
        }
        __builtin_amdgcn_sched_barrier(0);
        o[d] = __builtin_amdgcn_mfma_f32_32x32x16_bf16(pa0, vf[d][0], o[d], 0, 0, 0);
        o[d] = __builtin_amdgcn_mfma_f32_32x32x16_bf16(pa1, vf[d][1], o[d], 0, 0, 0);
        o[d] = __builtin_amdgcn_mfma_f32_32x32x16_bf16(pa2, vf[d][2], o[d], 0, 0, 0);
        o[d] = __builtin_amdgcn_mfma_f32_32x32x16_bf16(pa3, vf[d][3], o[d], 0, 0, 0);
        __builtin_amdgcn_sched_barrier(0);
    }
}

__device__ __forceinline__ void moba_unit(const bf16_t* __restrict__ proj, const LAS float* ksl, bf16_t* __restrict__ mixed, float* __restrict__ ssqA,
                                          int b, int h, int own, LAS char* lds, LAS float* wsf_all) {
    const int tid = threadIdx.x, lane = tid & 63, r32 = lane & 31, hi = lane >> 5, w = __builtin_amdgcn_readfirstlane(tid >> 6);
    LAS float* wsf = wsf_all + w * 64;
    const unsigned lds0 = (unsigned)(size_t)lds;
    const size_t rowb = (size_t)b * SEQ; const int q0 = own * 256;
    const int NT = 4 * (own + 1);
    const int krow = 8 * w + (lane >> 3);
    const bf16_t* hb = proj + ((size_t)(b * 8 + h) * SEQ) * 64;
    const bf16_t* ksrc = hb + pg8::PREG + krow * 64 + (((lane & 7) ^ ((krow >> 1) & 7)) << 3);
    const bf16_t* vsrc = hb + 2 * pg8::PREG + (16 * (w & 3) + (lane >> 2)) * 64 + (w >> 2) * 32 + (lane & 3) * 8;
    const unsigned dst0 = lds0 + w * 1024;
#define MOBA_DMA(s_) do { const int T_ = NT - 1 - (s_); const unsigned d_ = (unsigned)__builtin_amdgcn_readfirstlane(dst0 + ((s_) & 3) * 16384); \
        glds16(ksrc + T_ * 4096, d_); glds16(vsrc + T_ * 4096, d_ + 8192); } while (0)
    MOBA_DMA(0); MOBA_DMA(1); MOBA_DMA(2);
    const bf16_t* Qp = hb + (q0 + 32 * w + r32) * 64;
    bf16x8 qr[4];
#pragma unroll
    for (int s = 0; s < 4; ++s) qr[s] = *(const bf16x8*)(Qp + 16 * s + 8 * hi);
#pragma unroll
    for (int s = 0; s < 4; ++s) asm volatile("" : "+v"(qr[s]));
    int selmask = 0xff;
    if (own > 3) {
        float t1 = -INFINITY, t2 = -INFINITY, t3 = -INFINITY; int i1 = 0, i2 = 0, i3 = 0;
#pragma unroll 1
        for (int n = 0; n < own; ++n) {
            const LAS float* k0 = ksl + n * 64 + 8 * hi;
            float a = 0.f;
#pragma unroll
            for (int s = 0; s < 4; ++s) {
                const f32x4 x0 = *(const LAS f32x4*)(k0 + 16 * s), x1 = *(const LAS f32x4*)(k0 + 16 * s + 4);
                const u32x4 qq = __builtin_bit_cast(u32x4, qr[s]);
                a += bf_lo(qq.x) * x0[0] + bf_hi(qq.x) * x0[1] + bf_lo(qq.y) * x0[2] + bf_hi(qq.y) * x0[3] + bf_lo(qq.z) * x1[0] + bf_hi(qq.z) * x1[1] + bf_lo(qq.w) * x1[2] + bf_hi(qq.w) * x1[3];
            }
            a = xhalf_sum(a);
            const bool g1 = a > t1, g2 = a > t2, g3 = a > t3;
            t3 = g2 ? t2 : (g3 ? a : t3); i3 = g2 ? i2 : (g3 ? n : i3);
            t2 = g1 ? t1 : (g2 ? a : t2); i2 = g1 ? i1 : (g2 ? n : i2);
            t1 = g1 ? a : t1;             i1 = g1 ? n : i1;
        }
        selmask = (1 << i1) | (1 << i2) | (1 << i3);
    }
    const float slope2 = __builtin_amdgcn_exp2f(-(float)(h + 1)) * LOG2E;
    int koff[4];
#pragma unroll
    for (int s = 0; s < 4; ++s) koff[s] = r32 * 128 + (((2 * s + hi) ^ ((r32 >> 1) & 7)) << 4);
    float mref = 0.f, l = 0.f; f32x16 o[2]; o[0] = f32x16{}; o[1] = f32x16{};
    const int qrel = 32 * w + r32;
    for (int s = 0; s < NT; ++s) {
        const int T = NT - 1 - s, rem = NT - 1 - s;
        if (rem >= 2) WAIT_BAR(4); else if (rem == 1) WAIT_BAR(2); else WAIT_BAR(0);
        if (s + 3 < NT) MOBA_DMA(s + 3);
        const int jb = T - 4 * own;
        const bool skip = jb >= 0 && (64 * jb > 32 * w + 31);
        if (!skip) {
            const LAS char* buf = lds + (s & 3) * 16384;
            const bool sel = jb >= 0 || ((selmask >> (T >> 2)) & 1);
            const float u = sel ? (slope2 * (float)(64 * T - q0 - qrel) - mref) : -INFINITY;
            tile64<2>(buf, buf + 8192, koff, qr, slope2, u, 32.f * slope2, jb >= 0 && (64 * jb + 63 > 32 * w), 64 * jb, qrel, mref, l, o, wsf, r32, hi, lane);
        }
    }
#undef MOBA_DMA
    WAIT_BAR(0);
    l = xhalf_sum(l);
    if (hi == 0) wsf[32 + r32] = 1.0f / l;
    LDS_WAIT();
    LAS float* stg = (LAS float*)(lds + w * 8704);
#pragma unroll
    for (int r = 0; r < 16; ++r) { const int orow = crow(r, hi); const float il = wsf[32 + orow];
        stg[orow * 68 + r32] = o[0][r] * il; stg[orow * 68 + 32 + r32] = o[1][r] * il; }
    LDS_WAIT();
#pragma unroll
    for (int i = 0; i < 4; ++i) { const int row = 8 * i + (lane >> 3), ch = lane & 7; const LAS float* sp = stg + row * 68 + ch * 8;
      const f32x4 v0 = *(const LAS f32x4*)sp, v1 = *(const LAS f32x4*)(sp + 4);
      float q = (v0[0] * v0[0] + v0[1] * v0[1]) + (v0[2] * v0[2] + v0[3] * v0[3]) + (v1[0] * v1[0] + v1[1] * v1[1]) + (v1[2] * v1[2] + v1[3] * v1[3]);
      q += __shfl_xor(q, 1); q += __shfl_xor(q, 2); q += __shfl_xor(q, 4);
      const size_t grow = rowb + q0 + 32 * w + row;
      if (ch == 0) ssqA[grow * 8 + h] = q;
      *(u32x4*)(mixed + grow * DM + h * 64 + ch * 8) = pg8::pack8(v0, v1); }
    asm volatile("s_waitcnt lgkmcnt(0)\n\ts_barrier" ::: "memory");
}

__device__ __forceinline__ void diff_unit(const bf16_t* __restrict__ proj, bf16_t* __restrict__ mixed, const float* __restrict__ subln, float lam,
                                          int b, int h, int qt, LAS char* lds, LAS float* wsf_all) {
    const int tid = threadIdx.x, lane = tid & 63, r32 = lane & 31, hi = lane >> 5, w = __builtin_amdgcn_readfirstlane(tid >> 6), c = w >> 2, rg = w & 3;
    LAS float* wsf = wsf_all + w * 64;
    const unsigned lds0 = (unsigned)(size_t)lds;
    const size_t rowb = (size_t)b * SEQ; const int q0 = qt * 128;
    const int NT = 2 * (qt + 1);
    const int krow = 8 * w + (lane >> 3);
    const bf16_t* hb = proj + ((size_t)(b * 4 + h) * SEQ) * 128;
    const bf16_t* k0src = hb + 4 * pg8::PREG + krow * 64 + (((lane & 7) ^ ((krow >> 1) & 7)) << 3);
    const bf16_t* v0src = hb + 5 * pg8::PREG + (16 * (w & 3) + (lane >> 2)) * 128 + (w >> 2) * 32 + (lane & 3) * 8;
    const unsigned dst0 = lds0 + w * 1024;
#define DIFF_DMA(s_) do { const int T_ = NT - 1 - (s_); const unsigned d_ = (unsigned)__builtin_amdgcn_readfirstlane(dst0 + ((s_) & 3) * 32768); \
        glds16(k0src + T_ * 4096, d_); glds16(k0src + SEQ * 64 + T_ * 4096, d_ + 8192); glds16(v0src + T_ * 8192, d_ + 16384); glds16(v0src + 64 + T_ * 8192, d_ + 24576); } while (0)
    DIFF_DMA(0); DIFF_DMA(1); if (NT > 2) DIFF_DMA(2);
    const bf16_t* Qp = hb + 3 * pg8::PREG + (size_t)c * (SEQ * 64) + (q0 + 32 * rg + r32) * 64;
    bf16x8 qr[4];
#pragma unroll
    for (int s = 0; s < 4; ++s) qr[s] = *(const bf16x8*)(Qp + 16 * s + 8 * hi);
#pragma unroll
    for (int s = 0; s < 4; ++s) asm volatile("" : "+v"(qr[s]));
    const float slope2 = __builtin_amdgcn_exp2f(-2.0f * (float)(h + 1)) * LOG2E;
    int koff[4];
#pragma unroll
    for (int s = 0; s < 4; ++s) koff[s] = r32 * 128 + (((2 * s + hi) ^ ((r32 >> 1) & 7)) << 4);
    float mref = 0.f, l = 0.f; f32x16 o[4];
#pragma unroll
    for (int d = 0; d < 4; ++d) o[d] = f32x16{};
    const int qrel = 32 * rg + r32;
    for (int s = 0; s < NT; ++s) {
        const int T = NT - 1 - s, rem = NT - 1 - s;
        if (rem >= 2) WAIT_BAR(8); else if (rem == 1) WAIT_BAR(4); else WAIT_BAR(0);
        if (s + 3 < NT) DIFF_DMA(s + 3);
        const int jb = T - 2 * qt;
        const bool skip = jb >= 0 && (64 * jb > 32 * rg + 31);
        if (!skip) {
            const LAS char* buf = lds + (s & 3) * 32768;
            const float u = slope2 * (float)(64 * T - q0 - qrel) - mref;
            tile64<4>(buf + c * 8192, buf + 16384, koff, qr, slope2, u, 32.f * slope2, jb >= 0 && (64 * jb + 63 > 32 * rg), 64 * jb, qrel, mref, l, o, wsf, r32, hi, lane);
        }
    }
#undef DIFF_DMA
    WAIT_BAR(0);
    l = xhalf_sum(l);
    if (hi == 0) wsf[32 + r32] = (c == 1 ? lam : 1.0f) / l;
    LDS_WAIT();
    LAS float* Lb = (LAS float*)lds;
    if (c == 1) {
#pragma unroll
        for (int r = 0; r < 16; ++r) { const int orow = 32 * rg + crow(r, hi); const float il = wsf[32 + crow(r, hi)];
#pragma unroll
            for (int d = 0; d < 4; ++d) Lb[orow * 132 + 32 * d + r32] = o[d][r] * il; }
    }
    WAIT_BAR(0);
    if (c == 0) {
#pragma unroll
        for (int r = 0; r < 16; ++r) { const int orow = 32 * rg + crow(r, hi); const float il = wsf[32 + crow(r, hi)];
#pragma unroll
            for (int d = 0; d < 4; ++d) { const float v = o[d][r] * il - Lb[orow * 132 + 32 * d + r32]; Lb[orow * 132 + 32 * d + r32] = v; } }
    }
    WAIT_BAR(0);
    { const int ch = tid & 15; const f32x4 g0 = *(const f32x4*)(subln + ch * 8), g1 = *(const f32x4*)(subln + ch * 8 + 4);
#pragma unroll
      for (int i = 0; i < 4; ++i) { const int row = (tid >> 4) + 32 * i; const LAS float* sp = Lb + row * 132 + ch * 8;
        const f32x4 v0 = *(const LAS f32x4*)sp, v1 = *(const LAS f32x4*)(sp + 4);
        float q = (v0[0] * v0[0] + v0[1] * v0[1]) + (v0[2] * v0[2] + v0[3] * v0[3]) + (v1[0] * v1[0] + v1[1] * v1[1]) + (v1[2] * v1[2] + v1[3] * v1[3]);
        q += __shfl_xor(q, 1); q += __shfl_xor(q, 2); q += __shfl_xor(q, 4); q += __shfl_xor(q, 8);
        const float rs = 0.8f / sqrtf(q * (1.0f / 128.0f) + RMS_EPS);
        *(u32x4*)(mixed + (rowb + q0 + row) * DM + 512 + h * 128 + ch * 8) = pg8::pack8(v0 * g0 * rs, v1 * g1 * rs); } }
    asm volatile("s_waitcnt lgkmcnt(0)\n\ts_barrier" ::: "memory");
}

__device__ __forceinline__ void cross_unit(const bf16_t* __restrict__ qmem, const bf16_t* __restrict__ kvmem, unsigned char* __restrict__ omem, int b, int mh, int qt, LAS char* lds, LAS float* wsf_all) {
    const int tid = threadIdx.x, lane = tid & 63, r32 = lane & 31, hi = lane >> 5, w = __builtin_amdgcn_readfirstlane(tid >> 6);
    LAS float* wsf = wsf_all + w * 64;
    const unsigned lds0 = (unsigned)(size_t)lds;
    const size_t qrow = (size_t)b * SEQ + qt * 256 + 32 * w + r32;
    const bf16_t* Qp = qmem + qrow * DM + mh * 256;
    const bf16_t* kbase = kvmem + (size_t)b * MEMLEN * 2048 + mh * 256;
    const bf16_t* ksrc0; { const int row = 2 * w + (lane >> 5); ksrc0 = kbase + (size_t)row * 2048 + (((lane & 31) ^ (row & 15)) << 3); }
    const bf16_t* vsrc = kbase + 1024 + (size_t)(16 * (w & 3) + (lane >> 2)) * 2048 + (w >> 2) * 32 + (lane & 3) * 8;
    const unsigned dst0 = lds0 + w * 1024;
#define CROSS_DMA(st_) do { const unsigned d_ = (unsigned)__builtin_amdgcn_readfirstlane(dst0 + ((st_) & 3) * 32768); \
        if ((st_) < 4) { _Pragma("unroll") for (int j_ = 0; j_ < 4; ++j_) glds16(ksrc0 + (size_t)((st_) * 64 + 16 * j_) * 2048, d_ + j_ * 8192); } \
        else { _Pragma("unroll") for (int j_ = 0; j_ < 4; ++j_) glds16(vsrc + (size_t)((st_) - 4) * 64 * 2048 + j_ * 64, d_ + j_ * 8192); } } while (0)
    CROSS_DMA(0); CROSS_DMA(1); CROSS_DMA(2);
    bf16x8 qr[16];
#pragma unroll
    for (int s = 0; s < 16; ++s) qr[s] = *(const bf16x8*)(Qp + 16 * s + 8 * hi);
#pragma unroll
    for (int s = 0; s < 16; ++s) asm volatile("" : "+v"(qr[s]));
    int koff[8];
#pragma unroll
    for (int s = 0; s < 8; ++s) koff[s] = r32 * 512 + (((2 * s + hi) ^ (r32 & 15)) << 4);
    f32x16 p[8];
#pragma unroll
    for (int kt = 0; kt < 4; ++kt) {
        WAIT_BAR(8);
        CROSS_DMA(kt + 3);
        const LAS char* kp = lds + (kt & 3) * 32768;
        f32x16 a0 = f32x16{}, a1 = f32x16{};
#pragma unroll
        for (int s = 0; s < 16; ++s) {
            const bf16x8 k0 = *(const LAS bf16x8*)(kp + koff[s & 7] + (s >> 3) * 256), k1 = *(const LAS bf16x8*)(kp + koff[s & 7] + (s >> 3) * 256 + 16384);
            a0 = __builtin_amdgcn_mfma_f32_32x32x16_bf16(k0, qr[s], a0, 0, 0, 0);
            a1 = __builtin_amdgcn_mfma_f32_32x32x16_bf16(k1, qr[s], a1, 0, 0, 0);
            if ((s & 3) == 3) __builtin_amdgcn_sched_barrier(0);
        }
        p[2 * kt] = a0; p[2 * kt + 1] = a1;
    }
    float m = p[0][0];
#pragma unroll
    for (int i = 0; i < 8; ++i)
#pragma unroll
        for (int r = 0; r < 16; ++r) m = fmaxf(m, p[i][r]);
    m = xhalf_max(m);
    float l = 0.f;
#pragma unroll
    for (int i = 0; i < 8; ++i)
#pragma unroll
        for (int r = 0; r < 16; ++r) { p[i][r] = __builtin_amdgcn_exp2f(p[i][r] - m); l += p[i][r]; }
    l = xhalf_sum(l);
    bf16x8 pa[16];
#pragma unroll
    for (int i = 0; i < 8; ++i) { pa[2 * i] = pfrag(p[i], 0); pa[2 * i + 1] = pfrag(p[i], 8); }
    f32x16 o[8];
#pragma unroll
    for (int d = 0; d < 8; ++d) o[d] = f32x16{};
    const int vlane = ((lane >> 4) & 1) * 32 + (lane & 3) * 8 + (4 * hi + ((lane & 15) >> 2)) * 64;
#pragma unroll
    for (int vt = 0; vt < 4; ++vt) {
        if (vt == 0) { WAIT_BAR(8); CROSS_DMA(7); } else if (vt == 1) WAIT_BAR(8); else if (vt == 2) WAIT_BAR(4); else WAIT_BAR(0);
        const LAS char* vp = lds + ((4 + vt) & 3) * 32768 + vlane;
#pragma unroll
        for (int d = 0; d < 8; ++d) {
#pragma unroll
            for (int ks = 0; ks < 4; ++ks) o[d] = __builtin_amdgcn_mfma_f32_32x32x16_bf16(pa[4 * vt + ks], vfrag(vp + d * 4096 + ks * 1024), o[d], 0, 0, 0);
            if (d & 1) __builtin_amdgcn_sched_barrier(0);
        }
    }
#undef CROSS_DMA
    WAIT_BAR(0);
    if (hi == 0) wsf[32 + r32] = 1.0f / l;
    LDS_WAIT();
    LAS unsigned short* stg = (LAS unsigned short*)(lds + w * 8704);
    float il[16];
#pragma unroll
    for (int r = 0; r < 16; ++r) il[r] = wsf[32 + crow(r, hi)];
#pragma unroll
    for (int hf = 0; hf < 2; ++hf) {
#pragma unroll
        for (int r = 0; r < 16; ++r) { const int orow = crow(r, hi);
#pragma unroll
            for (int d = 0; d < 4; ++d) stg[orow * 136 + 32 * d + r32] = (unsigned short)(cvt_pk_bf16(o[4 * hf + d][r] * il[r], 0.f) & 0xffffu); }
        LDS_WAIT();
#pragma unroll
        for (int i = 0; i < 8; ++i) { const int row = (lane >> 4) + 4 * i, ch = lane & 15;
          const u32x4 ob = *(const LAS u32x4*)(stg + row * 136 + ch * 8);
          *(u32x2*)(omem + ((size_t)b * SEQ + qt * 256 + 32 * w + row) * DM + mh * 256 + hf * 128 + ch * 8) =
              (u32x2){pk4_fp8(bf_lo(ob.x) * SH8, bf_hi(ob.x) * SH8, bf_lo(ob.y) * SH8, bf_hi(ob.y) * SH8), pk4_fp8(bf_lo(ob.z) * SH8, bf_hi(ob.z) * SH8, bf_lo(ob.w) * SH8, bf_hi(ob.w) * SH8)}; }
        LDS_WAIT();
    }
    asm volatile("s_waitcnt lgkmcnt(0)\n\ts_barrier" ::: "memory");
}
}

typedef GAS unsigned gu32;
#define RLX_AGENT __ATOMIC_RELAXED, __HIP_MEMORY_SCOPE_AGENT
#define XB_TMO      128
#define XB_XCNT(j)  (256  + 64 * (j))
#define XB_XSUB(j)  (1280 + 64 * (j))
#define XB_XGEN(j)  (2304 + 64 * (j))
#define XB_TOP      3328
#define XB_TOPGEN   3392
#define XCD_BAR_WORDS 3456
#define XB_SPIN_CAP (1u << 18)
__device__ __forceinline__ unsigned xb_ld(unsigned* p)              { return __hip_atomic_load(p, __ATOMIC_RELAXED, __HIP_MEMORY_SCOPE_AGENT); }
__device__ __forceinline__ unsigned xb_add(unsigned* p, unsigned v) { return __hip_atomic_fetch_add(p, v, __ATOMIC_RELAXED, __HIP_MEMORY_SCOPE_AGENT); }
__device__ __forceinline__ unsigned xb_xcc_id() { return (unsigned)__builtin_amdgcn_s_getreg((3 << 11) | 20) & 0xFu; }
#define XB_SPIN(cond, bar) do { unsigned _sp = 0; while (cond) { __builtin_amdgcn_s_sleep(1); \
    if ((++_sp & 255u) == 0u) { if (xb_ld(&(bar)[XB_TMO])) break; if (_sp > XB_SPIN_CAP) { atomicAdd(&(bar)[XB_TMO], 1u); break; } } } } while (0)
struct XcdBarrier { unsigned* bar; unsigned x; volatile LAS unsigned* st; };
__device__ __forceinline__ XcdBarrier xcd_barrier_post(unsigned* bar, volatile LAS unsigned* st) {
    XcdBarrier b; b.bar = bar; b.x = xb_xcc_id(); b.st = st;
    if (threadIdx.x == 0) (void)xb_add(&bar[XB_XCNT(b.x)], 1u);
    return b;
}
__device__ __forceinline__ void xcd_barrier_complete(unsigned* bar, unsigned x, unsigned& nloc, unsigned& nx) {
    const unsigned G = gridDim.x * gridDim.y * gridDim.z;
    unsigned sum, cnt, mine, sp = 0u;
    for (;;) {
        sum = 0u; cnt = 0u; mine = 0u;
#pragma unroll
        for (unsigned j = 0; j < 16; ++j) { const unsigned c = xb_ld(&bar[XB_XCNT(j)]); sum += c; cnt += (c > 0u) ? 1u : 0u; mine = (j == x) ? c : mine; }
        if (sum == G) break;
        __builtin_amdgcn_s_sleep(1);
        if ((++sp & 255u) == 0u) { if (xb_ld(&bar[XB_TMO])) break; if (sp > XB_SPIN_CAP) { atomicAdd(&bar[XB_TMO], 1u); break; } }
    }
    nloc = mine > 0u ? mine : 1u; nx = cnt > 0u ? cnt : 1u;
}
__device__ __forceinline__ void xcd_barrier(const XcdBarrier& b) {
    asm volatile("s_waitcnt vmcnt(0)" ::: "memory");
    __syncthreads();
    if (threadIdx.x == 0) {
        unsigned* bar = b.bar;
        __builtin_amdgcn_s_waitcnt(0);
        unsigned nloc = b.st[0], nx = b.st[1];
        if (nloc == 0u) { xcd_barrier_complete(bar, b.x, nloc, nx); b.st[0] = nloc; b.st[1] = nx; }
        const unsigned old = xb_add(&bar[XB_XSUB(b.x)], 1u);
        const unsigned gen = old / nloc;
        if (old + 1u == (gen + 1u) * nloc) {
            __builtin_amdgcn_fence(__ATOMIC_RELEASE, "agent");
            asm volatile("s_waitcnt vmcnt(0)" ::: "memory");
            const unsigned og = xb_add(&bar[XB_TOP], 1u);
            const unsigned tg = og / nx;
            if (og + 1u == (tg + 1u) * nx) xb_add(&bar[XB_TOPGEN], 1u);
            else XB_SPIN(xb_ld(&bar[XB_TOPGEN]) == tg, bar);
            __builtin_amdgcn_fence(__ATOMIC_ACQUIRE, "agent");
            xb_add(&bar[XB_XGEN(b.x)], 1u);
            asm volatile("s_waitcnt vmcnt(0)" ::: "memory");
        } else {
            XB_SPIN(xb_ld(&bar[XB_XGEN(b.x)]) == gen, bar);
            __builtin_amdgcn_fence(__ATOMIC_ACQUIRE, "agent");
            asm volatile("s_waitcnt vmcnt(0)" ::: "memory");
        }
    }
    __syncthreads();
}

constexpr int NWAVES = 8;
__device__ __forceinline__ void p0_transpose_item(const float* W, int K, int N, bf16_t* WT, int rmode, const float* gain, int gain_n, LAS float* scr, int item, int lane) {
    const int nblk = N / 32, kb = item / nblk, nb = item % nblk, k0 = 64 * kb, n0 = 32 * nb;
    f32x4 v[8]; float gv[8];
#pragma unroll
    for (int i = 0; i < 8; ++i) { const int kk = 8 * i + (lane >> 3); v[i] = *(const f32x4*)(W + (size_t)(k0 + kk) * N + n0 + 4 * (lane & 7)); gv[i] = (gain && (k0 + kk) < gain_n) ? gain[k0 + kk] : 1.0f; }
#pragma unroll
    for (int i = 0; i < 8; ++i) { LAS float* d = scr + (8 * i + (lane >> 3)) * 33 + 4 * (lane & 7); d[0] = v[i][0] * gv[i]; d[1] = v[i][1] * gv[i]; d[2] = v[i][2] * gv[i]; d[3] = v[i][3] * gv[i]; }
    LDS_WAIT(); asm volatile("" ::: "memory");
    const int c = lane & 7;
#pragma unroll
    for (int j = 0; j < 4; ++j) { const int n = (lane >> 3) + 8 * j; const LAS float* s = scr + (8 * c) * 33 + n;
        u32x4 o; o.x = cvt_pk_bf16(s[0 * 33], s[1 * 33]); o.y = cvt_pk_bf16(s[2 * 33], s[3 * 33]); o.z = cvt_pk_bf16(s[4 * 33], s[5 * 33]); o.w = cvt_pk_bf16(s[6 * 33], s[7 * 33]);
        const int nn = n0 + n; const int row = rmode == 0 ? nn : ((nn >> 7) * 256 + (nn & 127) + (rmode == 2 ? 128 : 0));
        *(u32x4*)(WT + (size_t)row * K + k0 + 8 * c) = o; }
    LDS_WAIT(); asm volatile("" ::: "memory");
}
__device__ __forceinline__ void p0_transpose_item8(const float* W, int K, int N, unsigned char* WT, int rmode, const float* gain, float scale, LAS float* scr, int item, int lane) {
    const int nblk = N / 32, kb = item / nblk, nb = item % nblk, k0 = 64 * kb, n0 = 32 * nb;
    f32x4 v[8]; float gv[8];
#pragma unroll
    for (int i = 0; i < 8; ++i) { const int kk = 8 * i + (lane >> 3); v[i] = *(const f32x4*)(W + (size_t)(k0 + kk) * N + n0 + 4 * (lane & 7)); gv[i] = gain ? gain[k0 + kk] * scale : scale; }
#pragma unroll
    for (int i = 0; i < 8; ++i) { LAS float* d = scr + (8 * i + (lane >> 3)) * 33 + 4 * (lane & 7); d[0] = v[i][0] * gv[i]; d[1] = v[i][1] * gv[i]; d[2] = v[i][2] * gv[i]; d[3] = v[i][3] * gv[i]; }
    LDS_WAIT(); asm volatile("" ::: "memory");
    const int c = lane & 7;
#pragma unroll
    for (int j = 0; j < 4; ++j) { const int n = (lane >> 3) + 8 * j; const LAS float* sp = scr + (8 * c) * 33 + n;
        const u32x2 o = (u32x2){pk4_fp8(sp[0 * 33], sp[1 * 33], sp[2 * 33], sp[3 * 33]), pk4_fp8(sp[4 * 33], sp[5 * 33], sp[6 * 33], sp[7 * 33])};
        const int nn = n0 + n; const int row = rmode == 0 ? nn : ((nn >> 7) * 256 + (nn & 127) + (rmode == 2 ? 128 : 0));
        *(u32x2*)(WT + (size_t)row * K + k0 + 8 * c) = o; }
    LDS_WAIT(); asm volatile("" ::: "memory");
}
template <int RB>
__device__ __forceinline__ void rms_rows_to_bf16(const float* x, const float* gain, bf16_t* o, int row0, int rstride, int nrows, int lane, float* inv_out) {
    f32x4 v[RB][4]; const f32x4* gr = (const f32x4*)gain + lane;
#pragma unroll
    for (int r = 0; r < RB; ++r) { const int row = min(row0 + r * rstride, nrows - 1); const f32x4* xr = (const f32x4*)(x + (size_t)row * DM) + lane;
#pragma unroll
        for (int j = 0; j < 4; ++j) v[r][j] = xr[64 * j]; }
    f32x4 g[4];
#pragma unroll
    for (int j = 0; j < 4; ++j) g[j] = gr[64 * j];
#pragma unroll
    for (int r = 0; r < RB; ++r) { const int row = row0 + r * rstride; float s = 0.f;
#pragma unroll
        for (int j = 0; j < 4; ++j) s += (v[r][j][0] * v[r][j][0] + v[r][j][1] * v[r][j][1]) + (v[r][j][2] * v[r][j][2] + v[r][j][3] * v[r][j][3]);
        const float rms = sqrtf(wave_sum(s) * (1.0f / 1024.0f) + RMS_EPS), rstd = 1.0f / rms;
        if (row < nrows) { if (inv_out && lane == 0) inv_out[row] = rms;
            u32x2* o8 = (u32x2*)(o + (size_t)row * DM) + lane;
#pragma unroll
            for (int j = 0; j < 4; ++j) { const f32x4 y = v[r][j] * g[j] * rstd; u32x2 ov; ov.x = cvt_pk_bf16(y[0], y[1]); ov.y = cvt_pk_bf16(y[2], y[3]); o8[64 * j] = ov; } } }
}
template <int RB>
__device__ __forceinline__ void rms_rows_to_fp8(const float* x, const float* gain, unsigned char* o, int row0, int rstride, int nrows, int lane) {
    f32x4 v[RB][4]; const f32x4* gr = (const f32x4*)gain + lane;
#pragma unroll
    for (int r = 0; r < RB; ++r) { const int row = min(row0 + r * rstride, nrows - 1); const f32x4* xr = (const f32x4*)(x + (size_t)row * DM) + lane;
#pragma unroll
        for (int j = 0; j < 4; ++j) v[r][j] = xr[64 * j]; }
    f32x4 g[4];
#pragma unroll
    for (int j = 0; j < 4; ++j) g[j] = gr[64 * j];
#pragma unroll
    for (int r = 0; r < RB; ++r) { const int row = row0 + r * rstride; float s = 0.f;
#pragma unroll
        for (int j = 0; j < 4; ++j) s += (v[r][j][0] * v[r][j][0] + v[r][j][1] * v[r][j][1]) + (v[r][j][2] * v[r][j][2] + v[r][j][3] * v[r][j][3]);
        const float rstd = 1.0f / sqrtf(wave_sum(s) * (1.0f / 1024.0f) + RMS_EPS);
        if (row < nrows) { unsigned* o4 = (unsigned*)(o + (size_t)row * DM) + lane;
#pragma unroll
            for (int j = 0; j < 4; ++j) { const f32x4 y = v[r][j] * g[j] * rstd; o4[64 * j] = pk4_fp8(y[0], y[1], y[2], y[3]); } } }
}

struct Args { const float* in[25]; float* out; unsigned char* ws; int ph_lo, ph_hi; };
constexpr int NPHASE = 11;

__global__ void __launch_bounds__(NWAVES * 64, 2) hymba_fwd(Args args) {
    extern __shared__ __attribute__((aligned(16))) unsigned char lds_raw[];
    LAS unsigned char* lds = (LAS unsigned char*)lds_raw;
    volatile LAS unsigned* MISC = (volatile LAS unsigned*)(lds + MISC_OFF);
    LAS float* wsf_all = (LAS float*)(lds + MISC_OFF + 1024);
    LAS int* mtab = (LAS int*)(lds + MISC_OFF + 4096);
    const int tid = threadIdx.x, lane = tid & 63, wave = __builtin_amdgcn_readfirstlane(tid >> 6);
    const int G = gridDim.x; const int bx = blockIdx.x; const int vcu = (G % 8 == 0) ? (bx % 8) * (G / 8) + bx / 8 : bx;
    unsigned char* ws = args.ws;
    unsigned* ctl = (unsigned*)(ws + WS_CTL);
#pragma unroll
    for (int u = 0; u < (LDS_BYTES - MISC_OFF) / 16 / (NWAVES * 64); ++u) ((LAS u32x4*)(lds + MISC_OFF))[tid + u * NWAVES * 64] = (u32x4){0u, 0u, 0u, 0u};
    __syncthreads();
    XcdBarrier bar = xcd_barrier_post(ctl + CW_BAR, MISC + 8);
    const int lo = args.ph_lo, hi = args.ph_hi;
#ifndef PHMASK
#define PHMASK 0x7ff
#endif
#define IN(k) (((PHMASK >> (k)) & 1) && lo <= (k) && (k) < hi)
#define SEAM(k) do { if (IN(k) && IN((k) + 1)) xcd_barrier(bar); } while (0)
    const float* x = args.in[0]; const float* mem = args.in[1]; const float* norm_mix = args.in[2]; const float* w_in = args.in[3];
    const float* lq1 = args.in[4]; const float* lk1 = args.in[5]; const float* lq2 = args.in[6]; const float* lk2 = args.in[7];
    const float* diff_subln = args.in[8]; const float* norm_moba_out = args.in[9]; const float* w_out = args.in[10];
    const float* norm_mem_q = args.in[11]; const float* norm_mem_kv = args.in[12]; const float* w_mem_q = args.in[13]; const float* w_mem_kv = args.in[14]; const float* w_mem_o = args.in[15];
    const float* norm_ffn = args.in[16]; const float* w_rg = args.in[17]; const float* b_rg = args.in[18]; const float* w_re = args.in[19]; const float* b_re = args.in[20];
    const float* w_gate = args.in[21]; const float* w_up = args.in[22]; const float* w_down = args.in[23]; const float* norm_final = args.in[24];
    bf16_t* WinT = (bf16_t*)(ws + WS_WIN); bf16_t* WoutT = (bf16_t*)(ws + WS_WOUT); unsigned char* Wq8 = ws + WS_WQ; unsigned char* Wkv8 = ws + WS_WKV;
    unsigned char* Wo8 = ws + WS_WO; bf16_t* WrT = (bf16_t*)(ws + WS_WR); unsigned char* Wgu8 = ws + WS_WGU; unsigned char* Wd8 = ws + WS_WD;
    unsigned char* memn8 = ws + WS_MEMN; bf16_t* kvmem = (bf16_t*)(ws + WS_KVMEM);
    float* kms = (float*)(ws + WS_KMS); float* ssqA = (float*)(ws + WS_SSQA); float* ssq1 = (float*)(ws + WS_SSQ1); float* ssq2 = (float*)(ws + WS_SSQ2);
    int* rowtok = (int*)(ws + WS_ROWTOK); float* roww = (float*)(ws + WS_ROWW); float* rowrstd = (float*)(ws + WS_ROWRSTD);
    bf16_t* hn = (bf16_t*)(ws + WS_R0); bf16_t* mixed = (bf16_t*)(ws + WS_H2); float* invrx = (float*)(ws + WS_INVRX);
     unsigned char* y0 = ws + WS_R0 + 64 * MiB;
    bf16_t* h1 = (bf16_t*)(ws + WS_H1); unsigned char* y1 = ws + WS_H1; bf16_t* h2 = (bf16_t*)(ws + WS_H2);
    bf16_t* proj = (bf16_t*)(ws + WS_BIG); bf16_t* qmem = (bf16_t*)(ws + WS_QMEM); unsigned char* omem8 = ws + WS_OMEM; unsigned char* h1f8 = ws + WS_BIG + 256 * MiB; unsigned char* Hid8 = ws + WS_HID; unsigned char* h2f8 = ws + WS_R0;
    unsigned* ecnt = ctl + CW_ECNT;

    if (IN(0)) {
        LAS float* scr = (LAS float*)(lds + wave * 16384);
        const int gw = vcu * NWAVES + wave, NGW = G * NWAVES;
        constexpr int I_IN = 16 * 96, I_SQ = 16 * 32, I_KV = 16 * 64, I_GU = 16 * 16, I_DN = 8 * 32;
        constexpr int NITEMS = I_IN + 3 * I_SQ + I_KV + 32 + NEXP * (2 * I_GU + I_DN);
        for (int it = gw; it < NITEMS; it += NGW) {
            int r = it;
            if (r < I_IN) { p0_transpose_item(w_in, 1024, 3072, WinT, 0, nullptr, 0, scr, r, lane); continue; } r -= I_IN;
            if (r < I_SQ) { p0_transpose_item(w_out, 1024, 1024, WoutT, 0, norm_moba_out, 512, scr, r, lane); continue; } r -= I_SQ;
            if (r < I_SQ) { p0_transpose_item8(w_mem_q, 1024, 1024, Wq8, 0, norm_mem_q, SW8, scr, r, lane); continue; } r -= I_SQ;
            if (r < I_KV) { p0_transpose_item8(w_mem_kv, 1024, 2048, Wkv8, 0, nullptr, SW8, scr, r, lane); continue; } r -= I_KV;
            if (r < I_SQ) { p0_transpose_item8(w_mem_o, 1024, 1024, Wo8, 0, nullptr, SW8, scr, r, lane); continue; } r -= I_SQ;
            if (r < 32) {
                const int k0 = (r & 15) * 64;
                if (r < 16) { for (int n = 0; n < 4; ++n) { const int k = k0 + lane; WrT[(size_t)n * 1024 + k] = (bf16_t)(cvt_pk_bf16(w_rg[(size_t)k * 4 + n] * norm_ffn[k], 0.f) & 0xffffu); } }
                else { for (int n = 0; n < 32; ++n) { const int k = k0 + lane; WrT[(size_t)(4 + n) * 1024 + k] = (bf16_t)(cvt_pk_bf16(w_re[(size_t)k * 32 + n] * norm_ffn[k], 0.f) & 0xffffu); } }
                continue; } r -= 32;
            const int per = 2 * I_GU + I_DN, e = r / per; r -= e * per;
            if (r < I_GU) { p0_transpose_item8(w_gate + (size_t)e * 1024 * 512, 1024, 512, Wgu8 + (size_t)e * 1024 * 1024, 1, norm_ffn, SW8, scr, r, lane); continue; } r -= I_GU;
            if (r < I_GU) { p0_transpose_item8(w_up + (size_t)e * 1024 * 512, 1024, 512, Wgu8 + (size_t)e * 1024 * 1024, 2, norm_ffn, SW8, scr, r, lane); continue; } r -= I_GU;
            p0_transpose_item8(w_down + (size_t)e * 512 * 1024, 512, 1024, Wd8 + (size_t)e * 1024 * 512, 0, nullptr, SD8, scr, r, lane);
        }
        for (int mrow = gw; mrow < NTOK; mrow += 4 * NGW) rms_rows_to_bf16<4>(x, norm_mix, hn, mrow, NGW, NTOK, lane, invrx);
        for (int mrow = gw; mrow < NMEMROW; mrow += 4 * NGW) rms_rows_to_fp8<4>(mem, norm_mem_kv, memn8, mrow, NGW, NMEMROW, lane);
        for (int i = gw * 64 + lane; i < (256 - 36) * 1024 / 8; i += NGW * 64) ((u32x4*)(WrT + 36 * 1024))[i] = (u32x4){0u, 0u, 0u, 0u};
    }
    SEAM(0);
    if (IN(1)) {
        { pg8::DenseOrder S; S.init(hn, WinT, NTOK, PROJW, DM, G, bx); pg8::EpiProj E{proj, kms};
          pg8::gemm_phase<pg8::EpiProj, pg8::DenseOrder, true, false, false>(lds, DM, S, E); }
        { pg8::DenseOrder S; S.init(memn8, Wkv8, NMEMROW, 2048, DM, G, bx, 1, true); pg8::EpiPlain E{kvmem, 2048, 1.0f / SW8};
          pg8::gemm_phase<pg8::EpiPlain, pg8::DenseOrder, true, true, false, true>(lds, DM, S, E); }
    }
    SEAM(1);
    if (IN(2)) {
        float lam;
        { const int ln = (int)__builtin_amdgcn_mbcnt_hi(~0u, __builtin_amdgcn_mbcnt_lo(~0u, 0u));
          const float a = wave_sum(lq1[ln] * lk1[ln]), c = wave_sum(lq2[ln] * lk2[ln]); lam = __expf(a) - __expf(c) + 0.2f; }
        for (int v = vcu; v < 256; v += G) { const int bh = v >> 1, b = bh >> 2, h = bh & 3, par = v & 1;
#pragma unroll 1
            for (int i = 0; i < 8; ++i) { const int s = 2 * (i >> 1) + par; const int qt = (i & 1) ? 15 - s : s; att::diff_unit(proj, mixed, diff_subln, lam, b, h, qt, (LAS char*)lds, wsf_all); } }
        for (int v = vcu; v < 256; v += G) { const int b = v >> 3, h = v & 7;
            LAS float* ksl = (LAS float*)(lds + MISC_OFF + 6144);
            { const size_t ko = ((size_t)(b * 8 + (tid >> 6))) * 512 + h * 64 + (tid & 63); ksl[tid] = kms[ko] + kms[ko + (size_t)256 * 512]; }
            __syncthreads();
#pragma unroll 1
            for (int own = 7; own >= 0; --own) att::moba_unit(proj, ksl, mixed, ssqA, b, h, own, (LAS char*)lds, wsf_all); }
    }
    SEAM(2);
    if (IN(3)) {
        pg8::DenseOrder S; S.init(mixed, WoutT, NTOK, DM, DM, G, bx); pg8::EpiOut E{hn, invrx, norm_mix, ssqA, h1, ssq1, h1f8, lds + MISC_OFF + 16384};
        pg8::gemm_phase<pg8::EpiOut, pg8::DenseOrder, true, false, true>(lds, DM, S, E);
    }
    SEAM(3);
    if (IN(4)) {
        pg8::DenseOrder S; S.init(h1f8, Wq8, NTOK, DM, DM, G, bx, 1, true); pg8::EpiQ E{ssq1, qmem, lds + MISC_OFF};
        pg8::gemm_phase<pg8::EpiQ, pg8::DenseOrder, true, true, false, true>(lds, DM, S, E);
    }
    SEAM(4);
    if (IN(5)) {
        for (int u = vcu; u < 1024; u += G) { const int qt = u & 7, mh = (u >> 3) & 3, b = u >> 5; att::cross_unit(qmem, kvmem, omem8, b, mh, qt, (LAS char*)lds, wsf_all); }
    }
    SEAM(5);
    if (IN(6)) {
        pg8::DenseOrder S; S.init(omem8, Wo8, NTOK, DM, DM, G, bx, 1, true); pg8::EpiRes E{h1, h2, ssq2, h2f8, 1.0f / (SH8 * SW8)};
        pg8::gemm_phase<pg8::EpiRes, pg8::DenseOrder, true, true, false, true>(lds, DM, S, E);
    }
    SEAM(6);
    if (IN(7)) {
        pg8::DenseOrder S; S.init(h2, WrT, NTOK, 256, DM, G, bx); pg8::EpiRouter E{ssq2, b_rg, b_re, ecnt, rowtok, roww, rowrstd};
        pg8::gemm_phase<pg8::EpiRouter, pg8::DenseOrder, false, false, false>(lds, DM, S, E);
    }
    SEAM(7);
    if (IN(8) || IN(9)) {
        if (tid < 32) {
            const int c = (int)__hip_atomic_load(ecnt + tid, RLX_AGENT); const int nrt = (c + 255) >> 8;
            int incl = nrt;
#pragma unroll
            for (int o = 1; o < 32; o <<= 1) { const int t = __shfl_up(incl, o); if (tid >= o) incl += t; }
            const int excl = incl - nrt;
            mtab[tid] = c; mtab[32 + tid] = excl * 4; mtab[65 + tid] = excl * 256;
            if (tid == 31) { mtab[64] = incl * 4; mtab[97] = incl * 256; } }
        __syncthreads();
        if (tid < 16) { const int L = tid * G + bx; int e = -1, rt = 0, pn = 0, cn = 0, r0 = 0;
            if (L < mtab[64]) { e = 0; for (int k = 1; k < 32; ++k) if (L >= mtab[32 + k]) e = k;
                const int within = L - mtab[32 + e]; rt = within >> 2; pn = within & 3; cn = min(256, mtab[e] - rt * 256); r0 = mtab[65 + e] + rt * 256; }
            mtab[128 + 8 * tid] = e; mtab[128 + 8 * tid + 1] = rt; mtab[128 + 8 * tid + 2] = pn; mtab[128 + 8 * tid + 3] = cn; mtab[128 + 8 * tid + 4] = r0; }
        __syncthreads();
    }
    if (IN(8)) {
        pg8::MoeOrder S{mtab, (const char*)h2f8, (const char*)Wgu8, rowtok, DM, G, bx, true, 1}; pg8::EpiUp E{roww, rowrstd, Hid8, lds + MISC_OFF + 16384};
        pg8::gemm_phase<pg8::EpiUp, pg8::MoeOrder, true, true, false, true>(lds, DM, S, E);
    }
    SEAM(8);
    if (IN(9)) {
        pg8::MoeOrder S{mtab, (const char*)Hid8, (const char*)Wd8, rowtok, EFF, G, bx, false, 1}; pg8::EpiDown E{rowtok, y0, y1, lds + MISC_OFF + 16384};
        pg8::gemm_phase<pg8::EpiDown, pg8::MoeOrder, true, true, false, true>(lds, EFF, S, E);
    }
    SEAM(9);
    if (IN(10)) {
        const bool dead = xb_ld(&bar.bar[XB_TMO]) != 0u;
        const int ln = (int)__builtin_amdgcn_mbcnt_hi(~0u, __builtin_amdgcn_mbcnt_lo(~0u, 0u));
        const int gw = vcu * NWAVES + wave, NGW = G * NWAVES;
        for (int row = gw; row < NTOK; row += NGW) {
            const size_t off = (size_t)row * DM + 8 * ln;
            f32x4 v[4]; float s = 0.f;
#pragma unroll
            for (int j = 0; j < 2; ++j) { const u32x4 a = *(const u32x4*)(h2 + off + 512 * j); const u32x2 b = *(const u32x2*)(y0 + off + 512 * j), c = *(const u32x2*)(y1 + off + 512 * j);
                const f32x2 b0 = __builtin_amdgcn_cvt_pk_f32_fp8((int)b.x, false), b1 = __builtin_amdgcn_cvt_pk_f32_fp8((int)b.x, true), b2 = __builtin_amdgcn_cvt_pk_f32_fp8((int)b.y, false), b3 = __builtin_amdgcn_cvt_pk_f32_fp8((int)b.y, true);
                const f32x2 c0 = __builtin_amdgcn_cvt_pk_f32_fp8((int)c.x, false), c1 = __builtin_amdgcn_cvt_pk_f32_fp8((int)c.x, true), c2 = __builtin_amdgcn_cvt_pk_f32_fp8((int)c.y, false), c3 = __builtin_amdgcn_cvt_pk_f32_fp8((int)c.y, true);
                const float ys = 1.0f / SH8;
                v[2 * j] = (f32x4){bf_lo(a.x) + (b0[0] + c0[0]) * ys, bf_hi(a.x) + (b0[1] + c0[1]) * ys, bf_lo(a.y) + (b1[0] + c1[0]) * ys, bf_hi(a.y) + (b1[1] + c1[1]) * ys};
                v[2 * j + 1] = (f32x4){bf_lo(a.z) + (b2[0] + c2[0]) * ys, bf_hi(a.z) + (b2[1] + c2[1]) * ys, bf_lo(a.w) + (b3[0] + c3[0]) * ys, bf_hi(a.w) + (b3[1] + c3[1]) * ys}; }
#pragma unroll
            for (int j = 0; j < 4; ++j) s += (v[j][0] * v[j][0] + v[j][1] * v[j][1]) + (v[j][2] * v[j][2] + v[j][3] * v[j][3]);
            float rstd = 1.0f / sqrtf(wave_sum(s) * (1.0f / 1024.0f) + RMS_EPS);
            if (dead) rstd = __builtin_nanf("");
#pragma unroll
            for (int j = 0; j < 2; ++j) { const f32x4 g0 = *(const f32x4*)(norm_final + 8 * ln + 512 * j), g1 = *(const f32x4*)(norm_final + 8 * ln + 512 * j + 4);
                *(f32x4*)(args.out + off + 512 * j) = v[2 * j] * g0 * rstd; *(f32x4*)(args.out + off + 512 * j + 4) = v[2 * j + 1] * g1 * rstd; }
        }
    }
#undef IN
#undef SEAM
}

extern "C" void kernel_launch(void* const* d_in, const int* in_sizes, int n_in, void* d_out, int out_size, void* d_ws, size_t ws_size, hipStream_t stream) {
    static int grid = 0;
    if (grid == 0) {
        if (n_in != 25 || out_size != NTOK * DM || ws_size < WS_END) { fprintf(stderr, "kernel_launch: unexpected shapes (n_in %d out %d ws %zu)\n", n_in, out_size, ws_size); grid = -1; return; }
        int dev = 0, cus = 0, per_cu = 0;
        if (hipGetDevice(&dev) != hipSuccess || hipDeviceGetAttribute(&cus, hipDeviceAttributeMultiprocessorCount, dev) != hipSuccess) { grid = -1; return; }
        if (hipFuncSetAttribute((const void*)hymba_fwd, hipFuncAttributeMaxDynamicSharedMemorySize, LDS_BYTES) != hipSuccess) { fprintf(stderr, "kernel_launch: hipFuncSetAttribute failed\n"); grid = -1; return; }
        if (hipOccupancyMaxActiveBlocksPerMultiprocessor(&per_cu, (const void*)hymba_fwd, NWAVES * 64, LDS_BYTES) != hipSuccess || per_cu < 1) fprintf(stderr, "kernel_launch: occupancy query reports %d\n", per_cu);
        (void)hipGetLastError();
        grid = cus;
        if (grid != 256) { fprintf(stderr, "kernel_launch: expected 256 CUs, got %d\n", cus); if (grid > 256) grid = 256; }
    }
    if (grid < 0) return;
    if (hipMemsetAsync((char*)d_ws + WS_CTL, 0, CTL_ZERO_BYTES, stream) != hipSuccess) return;
    Args a{};
    for (int i = 0; i < 25; ++i) a.in[i] = (const float*)d_in[i];
    a.out = (float*)d_out; a.ws = (unsigned char*)d_ws;
    a.ph_lo = 0; a.ph_hi = NPHASE;
    hipLaunchKernelGGL(hymba_fwd, dim3(grid), dim3(NWAVES * 64), LDS_BYTES, stream, a);
}
```
